# Optimizing an MI355X kernel written in HIP

```python
import math
import jax
import jax.numpy as jnp
from jax import lax
import numpy as np

D_MODEL = 1024
BATCH = 2
SEQ = 16384
DEPTH = 4

GRID_W = 64
CTX_LEN = 256
BLK = 128
WINDOW = 128
N_BRANCH = 4
BRANCH_W = D_MODEL // 4
D_FF = 4 * D_MODEL
ROPE_BASE = 10000.0
NEG_INF = -1e30
A_HEADS = 4
A_DQK = BRANCH_W // (2 * A_HEADS)
A_DV = BRANCH_W // A_HEADS
B_HEADS = 4
B_D = BRANCH_W // B_HEADS
B_LORA_W = 64
B_LORA_A = 64
B_LORA_G = 128
B_GN_EPS = 64e-5
C_HEADS = 4
C_DK = BRANCH_W // (2 * C_HEADS)
C_DV = BRANCH_W // C_HEADS
D_QHEADS = 4
D_KVHEADS = 2
D_D = BRANCH_W // D_QHEADS

A_COLS = (A_HEADS * 2 * A_DQK, A_HEADS * 2 * A_DQK, A_HEADS * A_DV)
B_COLS = (BRANCH_W, BRANCH_W, BRANCH_W, B_LORA_W, B_LORA_W, B_LORA_A, B_LORA_A, B_LORA_G)
C_COLS = (C_HEADS * C_DK, C_HEADS * C_DK, C_HEADS * C_DV, BRANCH_W)
D_COLS = (D_QHEADS * D_D, D_KVHEADS * D_D, D_KVHEADS * D_D)
GROUP_COLS = (sum(A_COLS), sum(B_COLS), sum(C_COLS), sum(D_COLS), N_BRANCH * D_MODEL)
W_IN_COLS = sum(GROUP_COLS)

kernel_name = 'hybrid_diffusion_parallel_mixer'


def split_cols(x, sizes):
    return jnp.split(x, np.cumsum(sizes)[:-1].tolist(), axis=-1)


def rms_norm(x, g, eps=1e-6):
    xf = x.astype(jnp.float32)
    y = xf * lax.rsqrt(jnp.mean(xf * xf, axis=-1, keepdims=True) + eps)
    return (y * g.astype(jnp.float32)).astype(x.dtype)


def head_norm(x, g, b=None, eps=1e-5, center=True):
    xf = x.astype(jnp.float32)
    if center:
        xf = xf - jnp.mean(xf, axis=-1, keepdims=True)
    y = xf * lax.rsqrt(jnp.mean(xf * xf, axis=-1, keepdims=True) + eps)
    y = y.reshape(x.shape[:-2] + (-1,)) * g.astype(jnp.float32)
    if b is not None:
        y = y + b.astype(jnp.float32)
    return y.astype(x.dtype)


def rope_angles(pos, dim):
    inv_freq = ROPE_BASE ** (-jnp.arange(dim // 2, dtype=jnp.float32) / (dim // 2))
    return pos[:, None] * inv_freq[None, :]


def axial_rope_angles(rows, head_dim):
    row = jnp.repeat(jnp.arange(rows, dtype=jnp.float32), GRID_W)
    col = jnp.tile(jnp.arange(GRID_W, dtype=jnp.float32), rows)
    return rope_angles(row, head_dim // 2), rope_angles(col, head_dim // 2)


def rotate_half(x):
    x1, x2 = jnp.split(x, 2, axis=-1)
    return jnp.concatenate([-x2, x1], axis=-1)


def apply_rope(x, ang):
    full = jnp.concatenate([ang, ang], axis=-1)
    shp = (ang.shape[0],) + (1,) * (x.ndim - 3) + (full.shape[-1],)
    cos = jnp.cos(full).reshape(shp).astype(x.dtype)
    sin = jnp.sin(full).reshape(shp).astype(x.dtype)
    return x * cos + rotate_half(x) * sin


def apply_axial_rope(x, ang_r, ang_c):
    xr, xc = jnp.split(x, 2, axis=-1)
    return jnp.concatenate([apply_rope(xr, ang_r), apply_rope(xc, ang_c)], axis=-1)


def centred_shift(x):
    z = jnp.zeros_like(x[:, :1])
    prev = jnp.concatenate([z, x[:, :-1]], axis=1)
    nxt = jnp.concatenate([x[:, 1:], z], axis=1)
    return 0.5 * (prev + nxt)


def diff_attention(cols_l, cols_x, p, ang_r, ang_c, layer_idx, ctx_out):
    def heads(cols):
        q, k, v = split_cols(cols, A_COLS)
        sh = cols.shape[:2]
        return (q.reshape(sh + (A_HEADS, 2, A_DQK)), k.reshape(sh + (A_HEADS, 2, A_DQK)),
                v.reshape(sh + (A_HEADS, A_DV)))
    ql, kl, vl = heads(cols_l)
    qx, kx, vx = heads(cols_x)
    ql = apply_axial_rope(ql, ang_r, ang_c)
    kl = apply_axial_rope(kl, ang_r, ang_c)
    lam_init = 0.8 - 0.6 * math.exp(-0.3 * layer_idx)
    lq = p['diff_lam_q'].astype(jnp.float32)
    lk = p['diff_lam_k'].astype(jnp.float32)
    lam = jnp.exp(jnp.sum(lq[0] * lk[0])) - jnp.exp(jnp.sum(lq[1] * lk[1])) + lam_init
    scale = A_DQK ** -0.5

    def attend(q, k, v):
        s = jnp.einsum('bqhcd,bkhcd->bhcqk', q, k).astype(jnp.float32) * scale
        pr = jax.nn.softmax(s, axis=-1)
        wgt = (pr[:, :, 0] - lam * pr[:, :, 1]).astype(v.dtype)
        return jnp.einsum('bhqk,bkhd->bqhd', wgt, v)

    B, S = cols_l.shape[:2]
    nb = S // BLK
    k_all = jnp.concatenate([kx, kl], axis=1)
    v_all = jnp.concatenate([vx, vl], axis=1)
    q_blocks = jnp.swapaxes(ql.reshape(B, nb, BLK, A_HEADS, 2, A_DQK), 0, 1)
    o_blocks = lax.map(lambda qb: attend(qb, k_all, v_all), q_blocks)
    o_l = jnp.swapaxes(o_blocks, 0, 1).reshape(B, S, A_HEADS, A_DV)

    def finish(o):
        return head_norm(o, p['diff_subln'], center=False) * (1.0 - lam_init)
    y_l = finish(o_l)
    y_x = finish(attend(qx, kx, vx)) if ctx_out else None
    return y_l, y_x


def rwkv7_scan(r, w, k, v, kk, b, s0, reverse):
    tm = lambda t: jnp.moveaxis(t.astype(jnp.float32), 1, 0)

    def step(S, inp):
        rt, wt, kt, vt, kkt, bt = inp
        sa = jnp.einsum('bhvk,bhk->bhv', S, -kkt)
        S = S * wt[:, :, None, :] + sa[..., None] * bt[:, :, None, :] + vt[..., None] * kt[:, :, None, :]
        return S, jnp.einsum('bhvk,bhk->bhv', S, rt)

    S, y = lax.scan(step, s0, (tm(r), tm(w), tm(k), tm(v), tm(kk), tm(b)), reverse=reverse)
    return S, jnp.moveaxis(y, 0, 1)


def rwkv7_time_mix(cols_l, cols_x, p, ctx_out):
    hd = lambda t: t.reshape(t.shape[:-1] + (B_HEADS, B_D))

    def prep(cols):
        xs = cols + (centred_shift(cols) - cols) * p['rwkv_mu']
        r, k, v, wl_f, wl_b, al_f, al_b, gl = split_cols(xs, B_COLS)
        kk = hd(k * p['rwkv_kk'])
        kk = kk * lax.rsqrt(jnp.maximum(jnp.sum(kk * kk, axis=-1, keepdims=True), 1e-12))
        dirs = []
        for d, (wl, al) in enumerate(((wl_f, al_f), (wl_b, al_b))):
            w = -jax.nn.softplus(-(p['rwkv_w0'][d] + jnp.tanh(wl) @ p['rwkv_w2'][d])) - 0.5
            a = jax.nn.sigmoid(p['rwkv_a0'][d] + al @ p['rwkv_a2'][d])
            kd = k * (1.0 + (a - 1.0) * p['rwkv_ka'])
            dirs.append((hd(jnp.exp(-jnp.exp(w))), hd(kd), kk * hd(a)))
        return hd(r), hd(v), kk, gl, dirs

    rl, vl, kkl, gll, dirs_l = prep(cols_l)
    rx, vx, kkx, glx, dirs_x = prep(cols_x)
    s0 = jnp.zeros((cols_l.shape[0], B_HEADS, B_D, B_D), jnp.float32)
    outs_l, outs_x = [], []
    for d, rev in enumerate((False, True)):
        dec_x, kd_x, b_x = dirs_x[d]
        dec_l, kd_l, b_l = dirs_l[d]
        s_x, y_x = rwkv7_scan(rx, dec_x, kd_x, vx, kkx, b_x, s0, rev)
        _, y_l = rwkv7_scan(rl, dec_l, kd_l, vl, kkl, b_l, s_x, rev)
        outs_l.append((y_l, kd_l))
        outs_x.append((y_x, kd_x))

    def finish(outs, r, v, gl):
        y = head_norm(outs[0][0] + outs[1][0], p['rwkv_lnx_g'], p['rwkv_lnx_b'], eps=B_GN_EPS).astype(v.dtype)
        bonus = sum(jnp.sum(r * kd * p['rwkv_rk'], axis=-1, keepdims=True) * v for _, kd in outs)
        gate = jax.nn.sigmoid(gl) @ p['rwkv_g2']
        return (y + bonus.reshape(y.shape)) * gate

    y_l = finish(outs_l, rl, vl, gll)
    y_x = finish(outs_x, rx, vx, glx) if ctx_out else None
    return y_l, y_x


def retention_chunkwise(q, k, v, log_g, s0):
    B, T, H, _ = q.shape
    n = T // BLK
    chunks = lambda t: jnp.swapaxes(t.astype(jnp.float32).reshape(B, n, BLK, H, t.shape[-1]), 0, 1)
    idx = jnp.arange(BLK, dtype=jnp.float32)
    rel = idx[:, None] - idx[None, :]
    dmat = jnp.where(rel[None] >= 0, jnp.exp(jnp.maximum(rel, 0.0)[None] * log_g[:, None, None]), 0.0)
    q_dec = jnp.exp((idx[:, None] + 1.0) * log_g[None, :])
    k_dec = jnp.exp((BLK - 1.0 - idx[:, None]) * log_g[None, :])
    c_dec = jnp.exp(BLK * log_g)

    def step(S, blk):
        qc, kc, vc = blk
        sc = jnp.einsum('bihd,bjhd->bhij', qc, kc) * dmat[None]
        o = jnp.einsum('bhij,bjhe->bihe', sc, vc) + jnp.einsum('bihd,bhde->bihe', qc * q_dec[None, :, :, None], S)
        S = S * c_dec[None, :, None, None] + jnp.einsum('bjhd,bjhe->bhde', kc * k_dec[None, :, :, None], vc)
        return S, o

    S, o = lax.scan(step, s0, (chunks(q), chunks(k), chunks(v)))
    return S, jnp.swapaxes(o, 0, 1).reshape(B, T, H, v.shape[-1])


def retention(cols_l, cols_x, p, ang, ctx_out):
    def heads(cols):
        q, k, v, g = split_cols(cols, C_COLS)
        sh = cols.shape[:2]
        return (q.reshape(sh + (C_HEADS, C_DK)), k.reshape(sh + (C_HEADS, C_DK)) * (C_DK ** -0.5),
                v.reshape(sh + (C_HEADS, C_DV)), g)
    ql, kl, vl, gl = heads(cols_l)
    qx, kx, vx, gx = heads(cols_x)
    ql = apply_rope(ql, ang)
    kl = apply_rope(kl, ang)
    log_g = jax.nn.log_sigmoid(p['ret_decay'].astype(jnp.float32))
    s0 = jnp.zeros((cols_l.shape[0], C_HEADS, C_DK, C_DV), jnp.float32)
    flip = lambda t: t[:, ::-1]
    s_xf, o_xf = retention_chunkwise(qx, kx, vx, log_g[0], s0)
    _, o_lf = retention_chunkwise(ql, kl, vl, log_g[0], s_xf)
    s_xb, o_xb = retention_chunkwise(flip(qx), flip(kx), flip(vx), log_g[1], s0)
    _, o_lb = retention_chunkwise(flip(ql), flip(kl), flip(vl), log_g[1], s_xb)

    def finish(o, g):
        return head_norm(o, p['ret_gn']).astype(g.dtype) * jax.nn.silu(g)
    y_l = finish(o_lf + flip(o_lb), gl)
    y_x = finish(o_xf + flip(o_xb), gx) if ctx_out else None
    return y_l, y_x


def window_gqa(cols_l, cols_x, p, ang_r, ang_c, ctx_out):
    G = D_QHEADS // D_KVHEADS

    def heads(cols):
        q, k, v = split_cols(cols, D_COLS)
        sh = cols.shape[:2]
        return (q.reshape(sh + (D_QHEADS, D_D)), k.reshape(sh + (D_KVHEADS, D_D)),
                v.reshape(sh + (D_KVHEADS, D_D)))
    ql, kl, vl = heads(cols_l)
    qx, kx, vx = heads(cols_x)
    ql = apply_axial_rope(ql, ang_r, ang_c)
    kl = apply_axial_rope(kl, ang_r, ang_c)
    scale = D_D ** -0.5
    sink = p['win_sink'].astype(jnp.float32).reshape(D_KVHEADS, G)
    B, S = cols_l.shape[:2]
    C = cols_x.shape[1]
    nb = S // BLK
    qb = ql.reshape(B, nb, BLK, D_KVHEADS, G, D_D)

    def band(t):
        tp = jnp.pad(t, ((0, 0), (BLK, BLK), (0, 0), (0, 0))).reshape(B, nb + 2, BLK, D_KVHEADS, D_D)
        return jnp.concatenate([tp[:, :-2], tp[:, 1:-1], tp[:, 2:]], axis=2)
    kb, vb = band(kl), band(vl)
    start = jnp.arange(nb)[:, None] * BLK
    qpos = start + jnp.arange(BLK)[None, :]
    kpos = start - BLK + jnp.arange(3 * BLK)[None, :]
    valid = ((jnp.abs(qpos[:, :, None] - kpos[:, None, :]) <= WINDOW)
             & (kpos[:, None, :] >= 0) & (kpos[:, None, :] < S))
    s_band = jnp.einsum('bnqhgd,bnkhd->bnhgqk', qb, kb).astype(jnp.float32) * scale
    s_band = jnp.where(valid[None, :, None, None], s_band, NEG_INF)
    s_ctx = jnp.einsum('bnqhgd,bchd->bnhgqc', qb, kx).astype(jnp.float32) * scale
    s_sink = jnp.broadcast_to(sink[None, None, :, :, None, None], s_ctx.shape[:-1] + (1,))
    pr = jax.nn.softmax(jnp.concatenate([s_ctx, s_band, s_sink], axis=-1), axis=-1)
    p_ctx = pr[..., :C].astype(vl.dtype)
    p_band = pr[..., C:C + 3 * BLK].astype(vl.dtype)
    o = (jnp.einsum('bnhgqc,bchd->bnqhgd', p_ctx, vx)
         + jnp.einsum('bnhgqk,bnkhd->bnqhgd', p_band, vb))
    y_l = o.reshape(B, S, D_QHEADS * D_D)
    if ctx_out:
        s = jnp.einsum('bqhgd,bkhd->bhgqk', qx.reshape(B, C, D_KVHEADS, G, D_D), kx).astype(jnp.float32) * scale
        s_sink_x = jnp.broadcast_to(sink[None, :, :, None, None], s.shape[:-1] + (1,))
        px = jax.nn.softmax(jnp.concatenate([s, s_sink_x], axis=-1), axis=-1)[..., :C].astype(vx.dtype)
        y_x = jnp.einsum('bhgqk,bkhd->bqhgd', px, vx).reshape(B, C, D_QHEADS * D_D)
    else:
        y_x = None
    return y_l, y_x


def merge_branches(ys, gates, p):
    m = sum(jax.nn.sigmoid(gates[..., n * D_MODEL:(n + 1) * D_MODEL]) * (y @ p['w_branch'][n])
            for n, y in enumerate(ys))
    return m @ p['w_out']


def token_mixer(h_lat, h_ctx, p, rope, layer_idx, ctx_out):
    a_r, a_c, d_r, d_c, ret_ang = rope
    a_l, b_l, c_l, d_l, gate_l = split_cols(h_lat @ p['w_in'], GROUP_COLS)
    a_x, b_x, c_x, d_x, gate_x = split_cols(h_ctx @ p['w_in'], GROUP_COLS)
    ya_l, ya_x = diff_attention(a_l, a_x, p, a_r, a_c, layer_idx, ctx_out)
    yb_l, yb_x = rwkv7_time_mix(b_l, b_x, p, ctx_out)
    yc_l, yc_x = retention(c_l, c_x, p, ret_ang, ctx_out)
    yd_l, yd_x = window_gqa(d_l, d_x, p, d_r, d_c, ctx_out)
    out_l = merge_branches((ya_l, yb_l, yc_l, yd_l), gate_l, p)
    out_x = merge_branches((ya_x, yb_x, yc_x, yd_x), gate_x, p) if ctx_out else None
    return out_l, out_x


def sq_relu_mlp(h, w_up, w_down):
    return jnp.square(jax.nn.relu(h @ w_up)) @ w_down


def setup_inputs(seed: int = 0) -> dict:
    key = jax.random.key(seed)
    keys = iter(jax.random.split(key, 48))
    nrm = lambda shape, s: s * jax.random.normal(next(keys), shape, jnp.float32)
    gain = lambda shape: 1.0 + nrm(shape, 0.02)
    L, D = DEPTH, D_MODEL
    decay_speed = jnp.asarray(-6.0 + 5.0 * np.linspace(0.0, 1.0, BRANCH_W) ** 0.85, jnp.float32)
    ret_base = jnp.asarray(np.log(2.0 ** (5.0 + np.arange(C_HEADS)) - 1.0), jnp.float32)
    return {
        'x': nrm((BATCH, SEQ, D), 1.0),
        'c': nrm((BATCH, D), 1.0),
        'ctx': nrm((BATCH, CTX_LEN, D), 1.0),
        'c_ctx': nrm((D,), 1.0),
        'ada_w': nrm((L, D, 6 * D), 0.5 * D ** -0.5),
        'ada_b': nrm((L, 6 * D), 0.02),
        'norm_pre_mix': gain((L, D)),
        'norm_post_mix': gain((L, D)),
        'norm_pre_mlp': gain((L, D)),
        'norm_post_mlp': gain((L, D)),
        'w_in': nrm((L, D, W_IN_COLS), D ** -0.5),
        'diff_lam_q': nrm((L, 2, A_DQK), 0.1),
        'diff_lam_k': nrm((L, 2, A_DQK), 0.1),
        'diff_subln': gain((L, A_HEADS * A_DV)),
        'rwkv_mu': jax.random.uniform(next(keys), (L, sum(B_COLS)), jnp.float32),
        'rwkv_w0': decay_speed[None, None, :] + nrm((L, 2, BRANCH_W), 0.1),
        'rwkv_w2': nrm((L, 2, B_LORA_W, BRANCH_W), 0.1),
        'rwkv_a0': nrm((L, 2, BRANCH_W), 0.1),
        'rwkv_a2': nrm((L, 2, B_LORA_A, BRANCH_W), 0.1),
        'rwkv_g2': nrm((L, B_LORA_G, BRANCH_W), B_LORA_G ** -0.5),
        'rwkv_kk': 0.85 + nrm((L, BRANCH_W), 0.02),
        'rwkv_ka': 1.0 + nrm((L, BRANCH_W), 0.02),
        'rwkv_rk': nrm((L, B_HEADS, B_D), 0.1),
        'rwkv_lnx_g': gain((L, BRANCH_W)),
        'rwkv_lnx_b': nrm((L, BRANCH_W), 0.02),
        'ret_decay': ret_base[None, None, :] + nrm((L, 2, C_HEADS), 0.05),
        'ret_gn': gain((L, C_HEADS * C_DV)),
        'win_sink': nrm((L, D_QHEADS), 0.5),
        'w_branch': nrm((L, N_BRANCH, BRANCH_W, D), BRANCH_W ** -0.5),
        'w_out': nrm((L, D, D), D ** -0.5),
        'w_up': nrm((L, D, D_FF), D ** -0.5),
        'w_down': nrm((L, D_FF, D), D_FF ** -0.5),
    }


def reference(x, c, ctx, c_ctx, ada_w, ada_b, norm_pre_mix, norm_post_mix, norm_pre_mlp, norm_post_mlp,
              w_in, diff_lam_q, diff_lam_k, diff_subln, rwkv_mu, rwkv_w0, rwkv_w2, rwkv_a0, rwkv_a2, rwkv_g2,
              rwkv_kk, rwkv_ka, rwkv_rk, rwkv_lnx_g, rwkv_lnx_b, ret_decay, ret_gn, win_sink,
              w_branch, w_out, w_up, w_down):
    n_lat = x.shape[1]
    rows = n_lat // GRID_W
    a_r, a_c = axial_rope_angles(rows, A_DQK)
    d_r, d_c = axial_rope_angles(rows, D_D)
    ret_ang = rope_angles(jnp.arange(n_lat, dtype=jnp.float32), C_DK)
    rope = (a_r, a_c, d_r, d_c, ret_ang)
    params = dict(w_in=w_in, diff_lam_q=diff_lam_q, diff_lam_k=diff_lam_k, diff_subln=diff_subln,
                  rwkv_mu=rwkv_mu, rwkv_w0=rwkv_w0, rwkv_w2=rwkv_w2, rwkv_a0=rwkv_a0, rwkv_a2=rwkv_a2,
                  rwkv_g2=rwkv_g2, rwkv_kk=rwkv_kk, rwkv_ka=rwkv_ka, rwkv_rk=rwkv_rk,
                  rwkv_lnx_g=rwkv_lnx_g, rwkv_lnx_b=rwkv_lnx_b, ret_decay=ret_decay, ret_gn=ret_gn,
                  win_sink=win_sink, w_branch=w_branch, w_out=w_out)
    cx = ctx
    for l in range(DEPTH):
        p = {name: arr[l] for name, arr in params.items()}
        ctx_out = l < DEPTH - 1
        mod_l = (jax.nn.silu(c) @ ada_w[l] + ada_b[l])[:, None, :]
        mod_x = (jax.nn.silu(c_ctx) @ ada_w[l] + ada_b[l])[None, None, :]
        sh1, sc1, gt1, sh2, sc2, gt2 = jnp.split(mod_l, 6, axis=-1)
        xsh1, xsc1, xgt1, xsh2, xsc2, xgt2 = jnp.split(mod_x, 6, axis=-1)
        h_l = rms_norm(x, norm_pre_mix[l]) * (1.0 + sc1) + sh1
        h_x = rms_norm(cx, norm_pre_mix[l]) * (1.0 + xsc1) + xsh1
        m_l, m_x = token_mixer(h_l, h_x, p, rope, l, ctx_out)
        x = x + gt1 * rms_norm(m_l, norm_post_mix[l])
        h_l = rms_norm(x, norm_pre_mlp[l]) * (1.0 + sc2) + sh2
        x = x + gt2 * rms_norm(sq_relu_mlp(h_l, w_up[l], w_down[l]), norm_post_mlp[l])
        if ctx_out:
            cx = cx + xgt1 * rms_norm(m_x, norm_post_mix[l])
            h_x = rms_norm(cx, norm_pre_mlp[l]) * (1.0 + xsc2) + xsh2
            cx = cx + xgt2 * rms_norm(sq_relu_mlp(h_x, w_up[l], w_down[l]), norm_post_mlp[l])
    return x
```

```cpp
#include <hip/hip_runtime.h>
#include <hip/hip_cooperative_groups.h>
#include <stdint.h>
#include <stdio.h>
namespace cg = cooperative_groups;

typedef unsigned short u16;
typedef __attribute__((ext_vector_type(8))) __bf16 bf8;
typedef __attribute__((ext_vector_type(2))) __bf16 bf2;
typedef __attribute__((ext_vector_type(2))) float f2;
typedef __attribute__((ext_vector_type(4))) float f4;
typedef __attribute__((ext_vector_type(16))) float f16;
typedef __attribute__((ext_vector_type(4))) unsigned u4;
typedef __attribute__((ext_vector_type(2))) unsigned u2;

#ifndef MULTI_LAUNCH
#define MULTI_LAUNCH 0
#endif

constexpr int DM = 1024, NB = 2, SEQ = 16384, CTX = 256, TT = SEQ + CTX, NR = NB * TT, DEPTH = 4;
constexpr int WINC = 7296, DFF = 4096;
constexpr int PACD = 2048, PCB = 1152;
constexpr size_t MiB = 1u << 20;
constexpr size_t OFF_CTXRES = 0, OFF_MOD = 2 * MiB, OFF_CTR = 2 * MiB + 512 * 1024, OFF_TAB = 3 * MiB, OFF_WA = 6 * MiB,
                 OFF_H = 25 * MiB, OFF_ACD = 90 * MiB, OFF_CB = 220 * MiB, OFF_SCAN = 294 * MiB, OFF_GB = 441 * MiB,
                 OFF_DS = 458 * MiB, OFF_SIN = 475 * MiB, OFF_WM = 484 * MiB,
                 OFF_M = OFF_SCAN, OFF_MO = OFF_CB, OFF_U = 90 * MiB, OFF_DN = 360 * MiB;
constexpr size_t ARR = (size_t)NR * 256;
constexpr float LOG2E = 1.4426950408889634f;
constexpr int LDT = 72;
constexpr int EPS = 132;
constexpr int SMEM_BYTES = 2 * 2 * 128 * LDT * 2 + 5376;

struct Params {
  const float *x, *c, *ctx, *c_ctx, *ada_w, *ada_b, *n_pre_mix, *n_post_mix, *n_pre_mlp, *n_post_mlp, *w_in,
      *lam_q, *lam_k, *subln, *mu, *w0, *w2, *a0, *a2, *g2, *rkk, *rka, *rrk, *lnx_g, *lnx_b, *ret_decay, *ret_gn,
      *win_sink, *w_branch, *w_out, *w_up, *w_down;
  float* out;
  unsigned char* ws;
};

__device__ __forceinline__ float bf2f(u16 h) { return __uint_as_float(((unsigned)h) << 16); }
__device__ __forceinline__ unsigned pk2(float a, float b) {
  bf2 r = __builtin_convertvector((f2){a, b}, bf2);
  return __builtin_bit_cast(unsigned, r);
}
__device__ __forceinline__ u16 f2bf(float a) { return (u16)(pk2(a, 0.f) & 0xffffu); }
__device__ __forceinline__ float lo16(unsigned x) { return __uint_as_float(x << 16); }
__device__ __forceinline__ float hi16(unsigned x) { return __uint_as_float(x & 0xffff0000u); }
__device__ __forceinline__ void store8(u16* dst, const float* v) {
  u4 o;
  o[0] = pk2(v[0], v[1]); o[1] = pk2(v[2], v[3]); o[2] = pk2(v[4], v[5]); o[3] = pk2(v[6], v[7]);
  *(u4*)dst = o;
}
__device__ __forceinline__ float wsum(float x) {
  x += __builtin_bit_cast(float, __builtin_amdgcn_update_dpp(0, __builtin_bit_cast(int, x), 0xB1, 0xF, 0xF, true));
  x += __builtin_bit_cast(float, __builtin_amdgcn_update_dpp(0, __builtin_bit_cast(int, x), 0x4E, 0xF, 0xF, true));
  x += __builtin_bit_cast(float, __builtin_amdgcn_update_dpp(0, __builtin_bit_cast(int, x), 0x141, 0xF, 0xF, true));
  x += __builtin_bit_cast(float, __builtin_amdgcn_update_dpp(0, __builtin_bit_cast(int, x), 0x140, 0xF, 0xF, true));
  x += __builtin_bit_cast(float, __builtin_amdgcn_update_dpp(0, __builtin_bit_cast(int, x), 0x142, 0xA, 0xF, false));
  x += __builtin_bit_cast(float, __builtin_amdgcn_update_dpp(0, __builtin_bit_cast(int, x), 0x143, 0xC, 0xF, false));
  return __builtin_bit_cast(float, __builtin_amdgcn_readlane(__builtin_bit_cast(int, x), 63));
}
__device__ __forceinline__ float xhalf_max(float v) {
  auto r = __builtin_amdgcn_permlane32_swap(__float_as_uint(v), __float_as_uint(v), false, false);
  return fmaxf(__uint_as_float(r[0]), __uint_as_float(r[1]));
}
__device__ __forceinline__ float xhalf_sum(float v) {
  auto r = __builtin_amdgcn_permlane32_swap(__float_as_uint(v), __float_as_uint(v), false, false);
  return __uint_as_float(r[0]) + __uint_as_float(r[1]);
}
__device__ __forceinline__ int ltid() { int t = threadIdx.x; asm volatile("" : "+v"(t)); return t; }
__device__ __forceinline__ float fexp2(float x) { return __builtin_amdgcn_exp2f(x); }
__device__ __forceinline__ float fsigmoid(float x) { return __builtin_amdgcn_rcpf(1.f + fexp2(-x * LOG2E)); }
__device__ __forceinline__ int swz23(int r) { return (r & 0x13) | ((r & 4) << 1) | ((r & 8) >> 1); }

__device__ __forceinline__ float* xrow(const Params& p, int row) {
  int b = row >= TT ? 1 : 0;
  int t = row - b * TT;
  if (t < CTX) return (float*)(p.ws + OFF_CTXRES) + (size_t)(b * CTX + t) * DM;
  return p.out + (size_t)(b * SEQ + t - CTX) * DM;
}
__device__ __forceinline__ const float* modrow(const Params& p, int layer, int row) {
  int b = row >= TT ? 1 : 0;
  int t = row - b * TT;
  int which = t < CTX ? 2 : b;
  return (const float*)(p.ws + OFF_MOD) + (size_t)(layer * 3 + which) * 6 * DM;
}

__device__ __forceinline__ bool gemm_tile_of(int k, int ntn, int& mt, int& nt) {
  const int x = blockIdx.x & 7, lb = blockIdx.x >> 3, nlb = gridDim.x >> 3;
  const int mstart = x * 32 + (x < 4 ? x : 4), mcount = 32 + (x < 4 ? 1 : 0);
  const int j = lb + k * nlb;
  if (j >= mcount * ntn) return false;
  int mg, rm, jj;
  if (j < 32 * ntn) { mg = j / (8 * ntn); rm = 8; jj = j - mg * 8 * ntn; }
  else { mg = 4; rm = 1; jj = j - 32 * ntn; }
  nt = jj / rm;
  mt = mstart + mg * 8 + (jj - nt * rm);
  return true;
}

template <int NI>
struct GemmPipe { u4 ra0[4], rb0[2 * NI], ra1[4], rb1[2 * NI]; };

template <int NI>
__device__ __forceinline__ void gemm_prefetch(GemmPipe<NI>& pp, const u16* __restrict__ A, int lda,
                                              const u16* __restrict__ B, int ldb) {
  const int tid = ltid();
  const int crow = tid >> 3, ckc = (tid & 7) * 8;
  const u16* Ap = A + (size_t)crow * lda + ckc;
  const u16* Bp = B + (size_t)crow * ldb + ckc;
  const size_t astep = (size_t)32 * lda, bstep = (size_t)32 * ldb;
#pragma unroll
  for (int i = 0; i < 4; i++) { pp.ra0[i] = *(const u4*)(Ap + i * astep); pp.ra1[i] = *(const u4*)(Ap + i * astep + 64); }
#pragma unroll
  for (int i = 0; i < 2 * NI; i++) { pp.rb0[i] = *(const u4*)(Bp + i * bstep); pp.rb1[i] = *(const u4*)(Bp + i * bstep + 64); }
}

template <int NI>
__device__ __forceinline__ void gemm_main(f16 (&acc)[2][NI], GemmPipe<NI>& pp, const u16* __restrict__ A, int lda,
                                          const u16* __restrict__ B, int ldb, int K, u16* sm) {
  const int tid = ltid(), lane = tid & 63, wid = tid >> 6, wm = wid >> 1, wn = wid & 1;
  const int r = lane & 31, hh = lane >> 5;
  u16* sa = sm;
  u16* sb = sm + 2 * 128 * LDT;
  const int nk = K >> 6;
  const int crow = tid >> 3, ckc = (tid & 7) * 8;
  const u16* Ap = A + (size_t)crow * lda + ckc;
  const u16* Bp = B + (size_t)crow * ldb + ckc;
  const size_t astep = (size_t)32 * lda, bstep = (size_t)32 * ldb;
  auto gload = [&](u4 (&ra)[4], u4 (&rb)[2 * NI], int kt) {
#pragma unroll
    for (int i = 0; i < 4; i++) ra[i] = *(const u4*)(Ap + i * astep + kt * 64);
#pragma unroll
    for (int i = 0; i < 2 * NI; i++) rb[i] = *(const u4*)(Bp + i * bstep + kt * 64);
  };
  auto swrite = [&](const u4 (&ra)[4], const u4 (&rb)[2 * NI], int buf) {
    const int nb = buf * 128 * LDT;
#pragma unroll
    for (int i = 0; i < 4; i++) *(u4*)(sa + nb + (crow + 32 * i) * LDT + ckc) = ra[i];
#pragma unroll
    for (int i = 0; i < 2 * NI; i++) *(u4*)(sb + nb + (crow + 32 * i) * LDT + ckc) = rb[i];
  };
  auto compute = [&](int buf) {
    const u16* a0 = sa + buf * 128 * LDT + (64 * wm + r) * LDT + 8 * hh;
    const u16* b0 = sb + buf * 128 * LDT + (32 * NI * wn + r) * LDT + 8 * hh;
#pragma unroll
    for (int s = 0; s < 4; s++) {
      bf8 af[2], bfr[NI];
#pragma unroll
      for (int mi = 0; mi < 2; mi++) af[mi] = *(const bf8*)(a0 + mi * 32 * LDT + 16 * s);
#pragma unroll
      for (int ni = 0; ni < NI; ni++) bfr[ni] = *(const bf8*)(b0 + ni * 32 * LDT + 16 * s);
#pragma unroll
      for (int mi = 0; mi < 2; mi++)
#pragma unroll
        for (int ni = 0; ni < NI; ni++)
          acc[mi][ni] = __builtin_amdgcn_mfma_f32_32x32x16_bf16(af[mi], bfr[ni], acc[mi][ni], 0, 0, 0);
    }
  };
  swrite(pp.ra0, pp.rb0, 0);
  __syncthreads();
  for (int kt = 0; kt < nk; kt += 2) {
    if (kt + 2 < nk) gload(pp.ra0, pp.rb0, kt + 2);
    compute(0);
    swrite(pp.ra1, pp.rb1, 1);
    __syncthreads();
    if (kt + 3 < nk) gload(pp.ra1, pp.rb1, kt + 3);
    compute(1);
    if (kt + 2 < nk) swrite(pp.ra0, pp.rb0, 0);
    __syncthreads();
  }
}

template <int NI, class F>
__device__ __forceinline__ void gemm_epi(f16 (&acc)[2][NI], float* ep, F&& f) {
  const int tid = ltid(), lane = tid & 63, wid = tid >> 6, wm = wid >> 1, wn = wid & 1;
  const int r = lane & 31, hh = lane >> 5;
#pragma unroll
  for (int mi = 0; mi < 2; mi++)
#pragma unroll
    for (int ni = 0; ni < NI; ni++)
#pragma unroll
      for (int i = 0; i < 16; i++) {
        int row = 64 * wm + 32 * mi + (i & 3) + 8 * (i >> 2) + 4 * hh;
        int col = 32 * NI * wn + 32 * ni + r;
        ep[row * EPS + col] = acc[mi][ni][i];
      }
  __syncthreads();
  constexpr int CG = 8 * NI;
  for (int u = tid; u < 128 * CG; u += 256) {
    int row = u / CG, c8 = (u % CG) * 8;
    f(row, c8, ep + row * EPS + c8);
  }
  __syncthreads();
}

template <int NI>
__device__ __forceinline__ void zero_acc(f16 (&acc)[2][NI]) {
#pragma unroll
  for (int mi = 0; mi < 2; mi++)
#pragma unroll
    for (int ni = 0; ni < NI; ni++)
#pragma unroll
      for (int i = 0; i < 16; i++) acc[mi][ni][i] = 0.f;
}

__device__ __forceinline__ void wconv_tile(const float* __restrict__ src, u16* __restrict__ dst, int K, int N, int idx, float* tl) {
  const int tid = ltid();
  const int ntn = N >> 6;
  const int kt = idx / ntn, nt = idx - kt * ntn;
  const int k0 = kt * 64, n0 = nt * 64;
  const int a = tid >> 6, bb = tid & 63;
  float wv[16];
#pragma unroll
  for (int i = 0; i < 16; i++) wv[i] = src[(size_t)(k0 + i * 4 + a) * N + n0 + bb];
#pragma unroll
  for (int i = 0; i < 16; i++) tl[(i * 4 + a) * 65 + bb] = wv[i];
  __syncthreads();
#pragma unroll 4
  for (int i = 0; i < 16; i++) {
    int n = i * 4 + a;
    dst[(size_t)(n0 + n) * K + k0 + bb] = f2bf(tl[bb * 65 + n]);
  }
  __syncthreads();
}

__device__ __forceinline__ void wconv_layer(const Params& p, int l, unsigned char* smem) {
  float* tl = (float*)smem;
  u16* winT = (u16*)(p.ws + OFF_WA);
  u16* wbrT = winT + (size_t)WINC * DM;
  u16* woutT = wbrT + (size_t)4 * DM * 256;
  u16* wupT = (u16*)(p.ws + OFF_WM);
  u16* wdnT = wupT + (size_t)DFF * DM;
  const int n0 = 1824, n1 = n0 + 256, n2 = n1 + 256, n3 = n2 + 1024, n4 = n3 + 1024;
  for (int it = blockIdx.x; it < n4; it += gridDim.x) {
    if (it < n0) wconv_tile(p.w_in + (size_t)l * DM * WINC, winT, DM, WINC, it, tl);
    else if (it < n1) {
      int j = it - n0, n = j >> 6;
      wconv_tile(p.w_branch + ((size_t)l * 4 + n) * 256 * DM, wbrT + (size_t)n * DM * 256, 256, DM, j & 63, tl);
    } else if (it < n2) wconv_tile(p.w_out + (size_t)l * DM * DM, woutT, DM, DM, it - n1, tl);
    else if (it < n3) wconv_tile(p.w_up + (size_t)l * DM * DFF, wupT, DM, DFF, it - n2, tl);
    else wconv_tile(p.w_down + (size_t)l * DFF * DM, wdnT, DFF, DM, it - n3, tl);
  }
}

__device__ __forceinline__ void phase_pro(const Params& p, unsigned char* smem) {
  const int tid = ltid(), lane = tid & 63, wid = tid >> 6;
  float* sil = (float*)smem;
  float* red = sil + 3 * DM;
  float* modv = (float*)(p.ws + OFF_MOD);
  for (int it = blockIdx.x; it < DEPTH * 96; it += gridDim.x) {
    int l = it / 96, cgp = it - l * 96;
    for (int i = tid; i < 3 * DM; i += 256) {
      int w = i >> 10, k = i & 1023;
      float v = w < 2 ? p.c[w * DM + k] : p.c_ctx[k];
      sil[i] = v * fsigmoid(v);
    }
    __syncthreads();
    const float* W = p.ada_w + (size_t)l * DM * 6 * DM + cgp * 64 + lane;
    float a0 = 0.f, a1 = 0.f, a2 = 0.f;
#pragma unroll 16
    for (int k = wid * 256; k < wid * 256 + 256; k++) {
      float w = W[(size_t)k * 6 * DM];
      a0 += sil[k] * w; a1 += sil[DM + k] * w; a2 += sil[2 * DM + k] * w;
    }
    red[(wid * 3 + 0) * 64 + lane] = a0; red[(wid * 3 + 1) * 64 + lane] = a1; red[(wid * 3 + 2) * 64 + lane] = a2;
    __syncthreads();
    if (tid < 192) {
      int w = tid >> 6;
      float s = red[(0 * 3 + w) * 64 + lane] + red[(1 * 3 + w) * 64 + lane] + red[(2 * 3 + w) * 64 + lane] + red[(3 * 3 + w) * 64 + lane];
      int col = cgp * 64 + lane;
      modv[(size_t)(l * 3 + w) * 6 * DM + col] = s + p.ada_b[(size_t)l * 6 * DM + col];
    }
    __syncthreads();
  }
  const size_t gtid = (size_t)blockIdx.x * 256 + tid, gsz = (size_t)gridDim.x * 256;
  {
    const f4* src = (const f4*)p.x; f4* dst = (f4*)p.out;
    for (size_t i = gtid; i < (size_t)NB * SEQ * DM / 4; i += gsz) dst[i] = src[i];
    const f4* s2 = (const f4*)p.ctx; f4* d2 = (f4*)(p.ws + OFF_CTXRES);
    for (size_t i = gtid; i < (size_t)NB * CTX * DM / 4; i += gsz) d2[i] = s2[i];
  }
  {
    f2* tabC = (f2*)(p.ws + OFF_TAB);
    f2* tabAr = tabC + 16384 * 16; f2* tabAc = tabAr + 256 * 8; f2* tabDr = tabAc + 64 * 8; f2* tabDc = tabDr + 256 * 16;
    const int total = 16384 * 16 + 256 * 8 + 64 * 8 + 256 * 16 + 64 * 16;
    for (size_t i = gtid; i < (size_t)total; i += gsz) {
      int e = (int)i; int pos, j, nf; f2* dst;
      if (e < 16384 * 16) { pos = e >> 4; j = e & 15; nf = 16; dst = tabC + e; }
      else if ((e -= 16384 * 16) < 256 * 8) { pos = e >> 3; j = e & 7; nf = 8; dst = tabAr + e; }
      else if ((e -= 256 * 8) < 64 * 8) { pos = e >> 3; j = e & 7; nf = 8; dst = tabAc + e; }
      else if ((e -= 64 * 8) < 256 * 16) { pos = e >> 4; j = e & 15; nf = 16; dst = tabDr + e; }
      else { e -= 256 * 16; pos = e >> 4; j = e & 15; nf = 16; dst = tabDc + e; }
      double base = nf == 8 ? 0.31622776601683794 : 0.5623413251903491;
      double f = 1.0;
      for (int q = 0; q < j; q++) f *= base;
      float inv = (float)f;
      float ang = (float)pos * inv;
      double rev = (double)ang * 0.15915494309189535;
      rev -= floor(rev);
      float rv = (float)rev;
      f2 cs; cs.x = __builtin_amdgcn_cosf(rv); cs.y = __builtin_amdgcn_sinf(rv);
      *dst = cs;
    }
  }
  wconv_layer(p, 0, smem);
}

__device__ __forceinline__ void phase_rows(const Params& p, int l, int mode) {
  const int tid = ltid(), lane = tid & 63, wid = __builtin_amdgcn_readfirstlane(tid >> 6);
  u16* H = (u16*)(p.ws + OFF_H);
  const u16* src = (const u16*)(p.ws + (mode == 1 ? OFF_MO : OFF_DN));
  for (int row = blockIdx.x * 4 + wid; row < NR; row += gridDim.x * 4) {
    float* xr = xrow(p, row);
    f4 xv[4];
#pragma unroll
    for (int i = 0; i < 4; i++) xv[i] = *(const f4*)(xr + lane * 4 + 256 * i);
    if (mode != 0) {
      const float* md = modrow(p, l, row);
      const float* gt = md + (mode == 1 ? 2 : 5) * DM;
      const float* gpost = (mode == 1 ? p.n_post_mix : p.n_post_mlp) + (size_t)l * DM;
      float mv[4][4]; float ss = 0.f;
#pragma unroll
      for (int i = 0; i < 4; i++) {
        u2 raw = *(const u2*)(src + (size_t)row * DM + lane * 4 + 256 * i);
        mv[i][0] = lo16(raw[0]); mv[i][1] = hi16(raw[0]); mv[i][2] = lo16(raw[1]); mv[i][3] = hi16(raw[1]);
#pragma unroll
        for (int j = 0; j < 4; j++) ss += mv[i][j] * mv[i][j];
      }
      ss = wsum(ss);
      float rs = rsqrtf(ss * (1.f / DM) + 1e-6f);
#pragma unroll
      for (int i = 0; i < 4; i++) {
        f4 g4 = *(const f4*)(gpost + lane * 4 + 256 * i);
        f4 t4 = *(const f4*)(gt + lane * 4 + 256 * i);
#pragma unroll
        for (int j = 0; j < 4; j++) xv[i][j] += t4[j] * (mv[i][j] * rs * g4[j]);
        *(f4*)(xr + lane * 4 + 256 * i) = xv[i];
      }
    }
    int ln = mode == 2 ? l + 1 : l;
    if (ln < DEPTH) {
      const float* md = modrow(p, ln, row);
      const float* sh = md + (mode == 1 ? 3 : 0) * DM;
      const float* sc = md + (mode == 1 ? 4 : 1) * DM;
      const float* gpre = (mode == 1 ? p.n_pre_mlp : p.n_pre_mix) + (size_t)ln * DM;
      float ss = 0.f;
#pragma unroll
      for (int i = 0; i < 4; i++)
#pragma unroll
        for (int j = 0; j < 4; j++) ss += xv[i][j] * xv[i][j];
      ss = wsum(ss);
      float rs = rsqrtf(ss * (1.f / DM) + 1e-6f);
#pragma unroll
      for (int i = 0; i < 4; i++) {
        f4 g4 = *(const f4*)(gpre + lane * 4 + 256 * i);
        f4 s4 = *(const f4*)(sh + lane * 4 + 256 * i);
        f4 c4 = *(const f4*)(sc + lane * 4 + 256 * i);
        float o[4];
#pragma unroll
        for (int j = 0; j < 4; j++) o[j] = xv[i][j] * rs * g4[j] * (1.f + c4[j]) + s4[j];
        u2 pk; pk[0] = pk2(o[0], o[1]); pk[1] = pk2(o[2], o[3]);
        *(u2*)(H + (size_t)row * DM + lane * 4 + 256 * i) = pk;
      }
    }
  }
}

__device__ __forceinline__ void phase_gemm1(const Params& p, int l, unsigned char* smem) {
  const u16* H = (const u16*)(p.ws + OFF_H);
  const u16* winT = (const u16*)(p.ws + OFF_WA);
  u16* ACD = (u16*)(p.ws + OFF_ACD);
  u16* CB = (u16*)(p.ws + OFF_CB);
  const f2* tabC = (const f2*)(p.ws + OFF_TAB);
  const f2* tabAr = tabC + 16384 * 16; const f2* tabAc = tabAr + 256 * 8; const f2* tabDr = tabAc + 64 * 8; const f2* tabDc = tabDr + 256 * 16;
  GemmPipe<2> pp;
  int mt, nt;
  bool have = gemm_tile_of(0, 25, mt, nt);
  if (have) gemm_prefetch<2>(pp, H + (size_t)mt * 128 * DM, DM, winT + (size_t)nt * 128 * DM, DM);
  for (int kk = 0; have; kk++) {
    const int m0 = mt * 128, n0 = nt * 128;
    f16 acc[2][2];
    zero_acc<2>(acc);
    gemm_main<2>(acc, pp, H + (size_t)m0 * DM, DM, winT + (size_t)n0 * DM, DM, DM, (u16*)smem);
    const int ntc = nt;
    have = gemm_tile_of(kk + 1, 25, mt, nt);
    if (have) gemm_prefetch<2>(pp, H + (size_t)mt * 128 * DM, DM, winT + (size_t)nt * 128 * DM, DM);
    {
      const int nt = ntc;
    int cls; float scale = 1.f; u16* dst; int dpitch;
    if (nt < 4) { cls = 1; if (nt < 2) scale = 0.17677669529663687f * LOG2E; }
    else if (nt == 15 || nt == 16) { cls = 2; if (nt == 16) scale = 0.17677669529663687f; }
    else if (nt >= 21 && nt < 24) { cls = 3; if (nt < 23) scale = 0.125f * LOG2E; }
    else cls = 0;
    if (n0 < 768) { dst = ACD + n0; dpitch = PACD; }
    else if (n0 < 1920) { dst = CB + (n0 - 768); dpitch = PCB; }
    else { dst = ACD + (n0 - 1152); dpitch = PACD; }
    gemm_epi<2>(acc, (float*)smem, [&](int row, int c8, const float* e) {
      const int grow = m0 + row;
      const int b = grow >= TT ? 1 : 0;
      const int t = grow - b * TT;
      float v[8];
      if (cls == 0 || t < CTX) {
#pragma unroll
        for (int i = 0; i < 8; i++) v[i] = e[i] * scale;
      } else {
        const int n = t - CTX;
        const f2* tb; bool first; int dist;
        if (cls == 1) { int ee = c8 & 31; int half = ee >> 4; first = (ee & 15) < 8; dist = 8; tb = half ? tabAc + (n & 63) * 8 : tabAr + (n >> 6) * 8; }
        else if (cls == 2) { int ee = c8 & 31; first = ee < 16; dist = 16; tb = tabC + n * 16 + (ee & 15); }
        else { int ee = c8 & 63; int half = ee >> 5; int i0 = ee & 31; first = i0 < 16; dist = 16; tb = (half ? tabDc + (n & 63) * 16 : tabDr + (n >> 6) * 16) + (i0 & 15); }
#pragma unroll
        for (int i = 0; i < 8; i++) {
          f2 cs = tb[i];
          float pp = first ? -e[i + dist] : e[i - dist];
          v[i] = (e[i] * cs.x + pp * cs.y) * scale;
        }
      }
      store8(dst + (size_t)grow * dpitch + c8, v);
    });
    }
  }
}

__device__ __forceinline__ void prepb_tile(const Params& p, int l, int tile, float* act) {
  const int c = ltid(), lane = c & 63;
  const u16* CB = (const u16*)(p.ws + OFF_CB);
  u16* scan = (u16*)(p.ws + OFF_SCAN);
  u16* GB = (u16*)(p.ws + OFF_GB);
  const int r0 = tile * 16;
  const int b = r0 >= TT ? 1 : 0;
  const int t0 = r0 - b * TT;
  const int seg0 = t0 < CTX ? 0 : CTX, seg1 = t0 < CTX ? CTX : TT;
  const float* mu = p.mu + (size_t)l * PCB;
  const float mu0 = mu[c], mu1 = mu[256 + c], mu2 = mu[512 + c], mu3 = mu[768 + c], mu4 = c < 128 ? mu[1024 + c] : 0.f;
  const float ckk = p.rkk[l * 256 + c], cka = p.rka[l * 256 + c];
  float* kls = act + 16 * 384;
  float* kkls = kls + 16 * 256;
  u16 raw[18][5];
#pragma unroll
  for (int j = 0; j < 18; j++) {
    const int t = t0 - 1 + j;
    const bool ok = t >= seg0 && t < seg1;
    const u16* rp = CB + (size_t)(b * TT + (ok ? t : t0)) * PCB;
    raw[j][0] = rp[c]; raw[j][1] = rp[256 + c]; raw[j][2] = rp[512 + c]; raw[j][3] = rp[768 + c];
    raw[j][4] = rp[1024 + (c & 127)];
    if (!ok) { raw[j][0] = 0; raw[j][1] = 0; raw[j][2] = 0; raw[j][3] = 0; raw[j][4] = 0; }
  }
#pragma unroll
  for (int j = 0; j < 16; j++) {
    const int t = t0 + j;
    const size_t orow = (size_t)(b * TT + t) * 256;
    const float cu0 = bf2f(raw[j + 1][0]), cu1 = bf2f(raw[j + 1][1]), cu2 = bf2f(raw[j + 1][2]), cu3 = bf2f(raw[j + 1][3]), cu4 = bf2f(raw[j + 1][4]);
    const float sm0 = 0.5f * (bf2f(raw[j][0]) + bf2f(raw[j + 2][0])), sm1 = 0.5f * (bf2f(raw[j][1]) + bf2f(raw[j + 2][1]));
    const float sm2 = 0.5f * (bf2f(raw[j][2]) + bf2f(raw[j + 2][2])), sm3 = 0.5f * (bf2f(raw[j][3]) + bf2f(raw[j + 2][3]));
    const float sm4 = 0.5f * (bf2f(raw[j][4]) + bf2f(raw[j + 2][4]));
    float xr = cu0 + (sm0 - cu0) * mu0;
    float xk = cu1 + (sm1 - cu1) * mu1;
    float xv = cu2 + (sm2 - cu2) * mu2;
    float x3 = cu3 + (sm3 - cu3) * mu3;
    float x4 = cu4 + (sm4 - cu4) * mu4;
    scan[0 * ARR + orow + c] = f2bf(xr);
    scan[1 * ARR + orow + c] = f2bf(xv);
    kls[j * 256 + c] = xk;
    float kk = xk * ckk;
    float ssq = wsum(kk * kk);
    kk *= rsqrtf(fmaxf(ssq, 1e-12f));
    kkls[j * 256 + c] = kk;
    scan[2 * ARR + orow + c] = f2bf(kk);
    act[j * 384 + c] = c < 128 ? (1.f - 2.f * __builtin_amdgcn_rcpf(1.f + __expf(2.f * x3))) : x3;
    if (c < 128) act[j * 384 + 256 + c] = fsigmoid(x4);
  }
  __syncthreads();
  const size_t obase = (size_t)(b * TT + t0) * 256 + c;
  {
    auto wptr = [&](int idx) -> const float* {
      if (idx < 8) {
        const int d = idx >> 2, isa = (idx >> 1) & 1, hf = idx & 1;
        return (isa ? p.a2 : p.w2) + ((size_t)(l * 2 + d) * 64 + hf * 32) * 256 + c;
      }
      return p.g2 + ((size_t)l * 128 + (idx - 8) * 32) * 256 + c;
    };
    auto aoff = [&](int idx) -> int {
      if (idx < 8) { const int d = idx >> 2, isa = (idx >> 1) & 1, hf = idx & 1; return (isa ? 128 : 0) + d * 64 + hf * 32; }
      return 256 + (idx - 8) * 32;
    };
    float wA[32], wB[32], acc[16];
#pragma unroll
    for (int k = 0; k < 32; k++) wA[k] = wptr(0)[k * 256];
#pragma unroll
    for (int j = 0; j < 16; j++) acc[j] = 0.f;
#pragma unroll
    for (int idx = 0; idx < 12; idx++) {
      if (idx + 1 < 12) {
        const float* wp = wptr(idx + 1);
        if ((idx & 1) == 0) {
#pragma unroll
          for (int k = 0; k < 32; k++) wB[k] = wp[k * 256];
        } else {
#pragma unroll
          for (int k = 0; k < 32; k++) wA[k] = wp[k * 256];
        }
      }
      const int ao = aoff(idx);
#pragma unroll
      for (int k = 0; k < 32; k += 4) {
#pragma unroll
        for (int j = 0; j < 16; j++) {
          f4 a = *(const f4*)(act + j * 384 + ao + k);
          if ((idx & 1) == 0) acc[j] += a[0] * wA[k] + a[1] * wA[k + 1] + a[2] * wA[k + 2] + a[3] * wA[k + 3];
          else acc[j] += a[0] * wB[k] + a[1] * wB[k + 1] + a[2] * wB[k + 2] + a[3] * wB[k + 3];
        }
      }
      if (idx == 1 || idx == 5) {
        const int d = idx >> 2;
        const float w0c = p.w0[(l * 2 + d) * 256 + c];
#pragma unroll
        for (int j = 0; j < 16; j++) {
          float xx = -(w0c + acc[j]);
          float sp = fmaxf(xx, 0.f) + __logf(1.f + __expf(-fabsf(xx)));
          float wlog = -sp - 0.5f;
          float lam = __expf(wlog) * LOG2E;
          scan[(3 + 3 * d) * ARR + obase + (size_t)j * 256] = f2bf(lam);
          acc[j] = 0.f;
        }
      } else if (idx == 3 || idx == 7) {
        const int d = idx >> 2;
        const float a0c = p.a0[(l * 2 + d) * 256 + c];
#pragma unroll
        for (int j = 0; j < 16; j++) {
          float a = fsigmoid(a0c + acc[j]);
          float kd = kls[j * 256 + c] * (1.f + (a - 1.f) * cka);
          scan[(4 + 3 * d) * ARR + obase + (size_t)j * 256] = f2bf(kd);
          scan[(5 + 3 * d) * ARR + obase + (size_t)j * 256] = f2bf(kkls[j * 256 + c] * a);
          acc[j] = 0.f;
        }
      } else if (idx == 11) {
#pragma unroll
        for (int j = 0; j < 16; j++) GB[obase + (size_t)j * 256] = f2bf(acc[j]);
      }
    }
  }
  __syncthreads();
}

__device__ __forceinline__ float ret_lg(const Params& p, int l, int d, int h) {
  float x = p.ret_decay[(l * 2 + d) * 4 + h];
  return -__log2f(1.f + __expf(-x));
}
__device__ __forceinline__ void retc1_item(const Params& p, int l, int item, float* sm) {
  const int tid = ltid();
  const int h = item & 3, bb = item >> 2;
  const int b = bb / 130, blk = bb - b * 130;
  const u16* ACD = (const u16*)(p.ws + OFF_ACD);
  float* Ks = sm;
  float* Vs = sm + 128 * 32;
  float* dec = Vs + 128 * 64;
  const size_t row0 = (size_t)b * TT + blk * 128;
  const float lgf = ret_lg(p, l, 0, h), lgb = ret_lg(p, l, 1, h);
  {
    u4 kv[2], vv[4];
#pragma unroll
    for (int i = 0; i < 2; i++) { const int ch = tid + 256 * i; kv[i] = *(const u4*)(ACD + (row0 + (ch >> 2)) * PACD + 896 + h * 32 + (ch & 3) * 8); }
#pragma unroll
    for (int i = 0; i < 4; i++) { const int ch = tid + 256 * i; vv[i] = *(const u4*)(ACD + (row0 + (ch >> 3)) * PACD + 1024 + h * 64 + (ch & 7) * 8); }
#pragma unroll
    for (int i = 0; i < 2; i++) {
      const int ch = tid + 256 * i, j = ch >> 2, q8 = (ch & 3) * 8;
#pragma unroll
      for (int e = 0; e < 4; e++) { Ks[j * 32 + q8 + 2 * e] = lo16(kv[i][e]); Ks[j * 32 + q8 + 2 * e + 1] = hi16(kv[i][e]); }
    }
#pragma unroll
    for (int i = 0; i < 4; i++) {
      const int ch = tid + 256 * i, j = ch >> 3, q8 = (ch & 7) * 8;
#pragma unroll
      for (int e = 0; e < 4; e++) { Vs[j * 64 + q8 + 2 * e] = lo16(vv[i][e]); Vs[j * 64 + q8 + 2 * e + 1] = hi16(vv[i][e]); }
    }
  }
  if (tid < 128) { dec[tid] = fexp2((127 - tid) * lgf); dec[128 + tid] = fexp2(tid * lgb); }
  __syncthreads();
  const int dv = tid & 63, dkg = tid >> 6;
  float af[8], ab[8];
#pragma unroll
  for (int i = 0; i < 8; i++) { af[i] = 0.f; ab[i] = 0.f; }
  for (int j = 0; j < 128; j++) {
    float v = Vs[j * 64 + dv];
    float vf = v * dec[j], vb = v * dec[128 + j];
    f4 k0 = *(const f4*)(Ks + j * 32 + dkg * 8), k1 = *(const f4*)(Ks + j * 32 + dkg * 8 + 4);
#pragma unroll
    for (int i = 0; i < 4; i++) { af[i] += k0[i] * vf; ab[i] += k0[i] * vb; af[4 + i] += k1[i] * vf; ab[4 + i] += k1[i] * vb; }
  }
  float* dS = (float*)(p.ws + OFF_DS);
  float* of = dS + ((size_t)(((b * 4 + h) * 2 + 0) * 130 + blk)) * 2048 + dv * 32 + dkg * 8;
  float* ob = dS + ((size_t)(((b * 4 + h) * 2 + 1) * 130 + blk)) * 2048 + dv * 32 + dkg * 8;
#pragma unroll
  for (int i = 0; i < 8; i++) { of[i] = af[i]; ob[i] = ab[i]; }
  __syncthreads();
}
__device__ __forceinline__ void retc2_item(const Params& p, int l, int item) {
  const int e = item * 256 + ltid();
  const int bhd = e >> 11, el = e & 2047;
  const int d = bhd & 1, h = (bhd >> 1) & 3;
  const float cdec = fexp2(128.f * ret_lg(p, l, d, h));
  const float* dS = (const float*)(p.ws + OFF_DS) + (size_t)bhd * 130 * 2048 + el;
  u16* Sin = (u16*)(p.ws + OFF_SIN) + (size_t)bhd * 130 * 2048 + el;
  float S = 0.f;
  for (int i0 = 0; i0 < 130; i0 += 13) {
    float dv[13];
#pragma unroll
    for (int u = 0; u < 13; u++) {
      const int i = i0 + u;
      const int blk = d == 0 ? i : (i == 0 ? 1 : (i == 1 ? 0 : 131 - i));
      dv[u] = dS[(size_t)blk * 2048];
    }
#pragma unroll
    for (int u = 0; u < 13; u++) {
      const int i = i0 + u;
      const int blk = d == 0 ? i : (i == 0 ? 1 : (i == 1 ? 0 : 131 - i));
      Sin[(size_t)blk * 2048] = f2bf(S);
      S = S * cdec + dv[u];
    }
  }
}
__device__ __forceinline__ void retc3_item(const Params& p, int l, int item, u16* sm) {
  const int tid = ltid(), lane = tid & 63, w = __builtin_amdgcn_readfirstlane(tid >> 6), r = lane & 31, hh = lane >> 5;
  const int h = item & 3, bb = item >> 2;
  const int b = bb / 130, blk = bb - b * 130;
  u16* ACD = (u16*)(p.ws + OFF_ACD);
  u16* Kt = sm;
  u16* Vt = sm + 128 * 40;
  const size_t row0 = (size_t)b * TT + blk * 128;
  const float lgf = ret_lg(p, l, 0, h), lgb = ret_lg(p, l, 1, h);
  const int iq = 32 * w + r;
  const size_t qrow = row0 + iq;
  u4 kst[2], vst[2][2], qraw[2], sfr[2][2][2];
  u2 graw[2][4];
#pragma unroll
  for (int i = 0; i < 2; i++) { const int cI = tid + 256 * i; kst[i] = *(const u4*)(ACD + (row0 + (cI >> 2)) * PACD + 896 + h * 32 + (cI & 3) * 8); }
#pragma unroll
  for (int i = 0; i < 2; i++) {
    const int u = tid + 256 * i, kp = u >> 3, dg = u & 7;
    vst[i][0] = *(const u4*)(ACD + (row0 + 2 * kp) * PACD + 1024 + h * 64 + dg * 8);
    vst[i][1] = *(const u4*)(ACD + (row0 + 2 * kp + 1) * PACD + 1024 + h * 64 + dg * 8);
  }
  qraw[0] = *(const u4*)(ACD + qrow * PACD + 768 + h * 32 + 8 * hh);
  qraw[1] = *(const u4*)(ACD + qrow * PACD + 768 + h * 32 + 16 + 8 * hh);
  {
    const u16* Sin = (const u16*)(p.ws + OFF_SIN);
#pragma unroll
    for (int d = 0; d < 2; d++)
#pragma unroll
      for (int s2 = 0; s2 < 2; s2++)
#pragma unroll
        for (int dt = 0; dt < 2; dt++)
          sfr[d][s2][dt] = *(const u4*)(Sin + ((size_t)(((b * 4 + h) * 2 + d) * 130 + blk)) * 2048 + (32 * dt + r) * 32 + 16 * s2 + 8 * hh);
  }
#pragma unroll
  for (int dt = 0; dt < 2; dt++)
#pragma unroll
    for (int i4 = 0; i4 < 4; i4++) graw[dt][i4] = *(const u2*)(ACD + qrow * PACD + 1280 + h * 64 + 32 * dt + 8 * i4 + 4 * hh);
#pragma unroll
  for (int i = 0; i < 2; i++) { const int cI = tid + 256 * i; *(u4*)(Kt + (cI >> 2) * 40 + (cI & 3) * 8) = kst[i]; }
#pragma unroll
  for (int i = 0; i < 2; i++) {
    const int u = tid + 256 * i, kp = u >> 3, dg = u & 7;
#pragma unroll
    for (int e = 0; e < 4; e++) {
      unsigned a = vst[i][0][e], c2 = vst[i][1][e];
      *(unsigned*)(Vt + (dg * 8 + 2 * e) * 136 + 2 * kp) = (a & 0xffffu) | (c2 << 16);
      *(unsigned*)(Vt + (dg * 8 + 2 * e + 1) * 136 + 2 * kp) = (a >> 16) | (c2 & 0xffff0000u);
    }
  }
  __syncthreads();
  f16 oacc[2];
#pragma unroll
  for (int i = 0; i < 16; i++) { oacc[0][i] = 0.f; oacc[1][i] = 0.f; }
#pragma unroll
  for (int kb = 0; kb < 4; kb++) {
    f16 st;
#pragma unroll
    for (int i = 0; i < 16; i++) st[i] = 0.f;
#pragma unroll
    for (int s = 0; s < 2; s++) {
      bf8 a = *(const bf8*)(Kt + (32 * kb + swz23(r)) * 40 + 16 * s + 8 * hh);
      st = __builtin_amdgcn_mfma_f32_32x32x16_bf16(a, __builtin_bit_cast(bf8, qraw[s]), st, 0, 0, 0);
    }
    u4 pb[2];
#pragma unroll
    for (int i = 0; i < 16; i++) {
      int key = 32 * kb + (i & 7) + 8 * hh + 16 * (i >> 3);
      int dd = iq - key;
      float wgt = dd > 0 ? fexp2((float)dd * lgf) : (dd < 0 ? fexp2((float)(-dd) * lgb) : 2.f);
      st[i] *= wgt;
    }
#pragma unroll
    for (int s = 0; s < 2; s++)
#pragma unroll
      for (int q = 0; q < 4; q++) pb[s][q] = pk2(st[8 * s + 2 * q], st[8 * s + 2 * q + 1]);
#pragma unroll
    for (int dt = 0; dt < 2; dt++)
#pragma unroll
      for (int s = 0; s < 2; s++) {
        bf8 a = *(const bf8*)(Vt + (32 * dt + r) * 136 + 32 * kb + 16 * s + 8 * hh);
        oacc[dt] = __builtin_amdgcn_mfma_f32_32x32x16_bf16(a, __builtin_bit_cast(bf8, pb[s]), oacc[dt], 0, 0, 0);
      }
  }
  {
    const float qdf = fexp2((float)(iq + 1) * lgf), qdb = fexp2((float)(128 - iq) * lgb);
#pragma unroll
    for (int d = 0; d < 2; d++) {
      const float qd = d == 0 ? qdf : qdb;
#pragma unroll
      for (int s = 0; s < 2; s++) {
        u4 qs;
#pragma unroll
        for (int q = 0; q < 4; q++) qs[q] = pk2(lo16(qraw[s][q]) * qd, hi16(qraw[s][q]) * qd);
#pragma unroll
        for (int dt = 0; dt < 2; dt++) {
          oacc[dt] = __builtin_amdgcn_mfma_f32_32x32x16_bf16(__builtin_bit_cast(bf8, sfr[d][s][dt]), __builtin_bit_cast(bf8, qs), oacc[dt], 0, 0, 0);
        }
      }
    }
  }
  float sum = 0.f;
#pragma unroll
  for (int dt = 0; dt < 2; dt++)
#pragma unroll
    for (int i = 0; i < 16; i++) sum += oacc[dt][i];
  sum = xhalf_sum(sum);
  const float mean = sum * (1.f / 64.f);
  float var = 0.f;
#pragma unroll
  for (int dt = 0; dt < 2; dt++)
#pragma unroll
    for (int i = 0; i < 16; i++) { float dlt = oacc[dt][i] - mean; var += dlt * dlt; }
  var = xhalf_sum(var) * (1.f / 64.f);
  const float rstd = rsqrtf(var + 1e-5f);
  const float* gn = p.ret_gn + l * 256 + h * 64;
#pragma unroll
  for (int dt = 0; dt < 2; dt++)
#pragma unroll
    for (int i4 = 0; i4 < 4; i4++) {
      const int dv = 32 * dt + 8 * i4 + 4 * hh;
      u16* gp = ACD + qrow * PACD + 1280 + h * 64 + dv;
      const u2 gr = graw[dt][i4];
      float g[4] = {lo16(gr[0]), hi16(gr[0]), lo16(gr[1]), hi16(gr[1])};
      float o[4];
#pragma unroll
      for (int q = 0; q < 4; q++) {
        float y = (oacc[dt][4 * i4 + q] - mean) * rstd * gn[dv + q];
        o[q] = y * g[q] * fsigmoid(g[q]);
      }
      u2 ov; ov[0] = pk2(o[0], o[1]); ov[1] = pk2(o[2], o[3]);
      *(u2*)gp = ov;
    }
  __syncthreads();
}

constexpr int SLOT = 64 * LDT;
constexpr int MABS = 68;
__device__ __forceinline__ int rw_row(int d, int b, int i) {
  int t = d == 0 ? i : (i < CTX ? CTX - 1 - i : TT + CTX - 1 - i);
  return b * TT + t;
}
template <bool PERM>
__device__ __forceinline__ void mm64(f16& acc, const u16* A, const u16* B, int tm, int tn, int r, int hh) {
  const int ar = PERM ? swz23(r) : r;
#pragma unroll
  for (int s = 0; s < 4; s++) {
    bf8 a = *(const bf8*)(A + (32 * tm + ar) * LDT + 16 * s + 8 * hh);
    bf8 bb = *(const bf8*)(B + (32 * tn + r) * LDT + 16 * s + 8 * hh);
    acc = __builtin_amdgcn_mfma_f32_32x32x16_bf16(a, bb, acc, 0, 0, 0);
  }
}
__device__ __forceinline__ void zero16(f16& a) {
#pragma unroll
  for (int i = 0; i < 16; i++) a[i] = 0.f;
}
template <int MASK>
__device__ __forceinline__ void put_tile(u16* dst, const f16& acc, int tm, int tn, int r, int hh) {
#pragma unroll
  for (int i = 0; i < 16; i++) {
    int row = 32 * tm + (i & 3) + 8 * (i >> 2) + 4 * hh, col = 32 * tn + r;
    float v = acc[i];
    if (MASK == 1 && !(row > col)) v = 0.f;
    if (MASK == 2 && !(row >= col)) v = 0.f;
    dst[row * LDT + col] = f2bf(v);
  }
}
template <int MASK>
__device__ __forceinline__ void put_tile_T(u16* dst, const f16& acc, int tm, int tn, int r, int hh) {
#pragma unroll
  for (int i4 = 0; i4 < 4; i4++) {
    const int row0 = 32 * tm + 8 * i4 + 4 * hh, col = 32 * tn + r;
    float v[4];
#pragma unroll
    for (int q = 0; q < 4; q++) {
      v[q] = acc[4 * i4 + q];
      if (MASK == 3 && !(((row0 + q) >> 4) > (col >> 4))) v[q] = 0.f;
    }
    u2 o; o[0] = pk2(v[0], v[1]); o[1] = pk2(v[2], v[3]);
    *(u2*)(dst + col * LDT + row0) = o;
  }
}

template <int MODE>
__device__ __forceinline__ void rwkv_chunk(const Params& p, int b, int h, int d, int c, u16* sm, f16& yout) {
  const int tid = ltid(), lane = tid & 63, w = __builtin_amdgcn_readfirstlane(tid >> 6), r = lane & 31, hh = lane >> 5;
  const int tm = w >> 1, tn = w & 1;
  u16 *x0 = sm, *x1 = sm + SLOT, *x2 = sm + 2 * SLOT, *x3 = sm + 3 * SLOT, *x4 = sm + 4 * SLOT, *x5 = sm + 5 * SLOT,
      *x6 = sm + 6 * SLOT, *x7 = sm + 7 * SLOT;
  float* dg = (float*)(sm + 8 * SLOT);
  float* qs = dg + 1024;
  float* wc = qs + 256;
  u16* AHT = MODE == 0 ? x6 : x5;
  u16* LTN = MODE == 0 ? x7 : x6;
  u16* TD = MODE == 0 ? x2 : x1;
  const u16* scan = (const u16*)(p.ws + OFF_SCAN);
  unsigned char* cbase = p.ws + OFF_CB + ((size_t)(((b * 4 + h) * 2 + d) * 260 + c)) * 16384;
  {
    const int k = lane, q = w, col = h * 64 + k;
    float lam[16], run = 0.f;
#pragma unroll
    for (int u = 0; u < 16; u++) {
      size_t ro = (size_t)rw_row(d, b, 64 * c + 16 * q + u) * 256 + col;
      lam[u] = bf2f(scan[(size_t)(3 + 3 * d) * ARR + ro]);
      run += lam[u];
    }
    u16 rkk[16], rbb[16], rkd[16], rvv[16], rrr[16];
#pragma unroll
    for (int u = 0; u < 16; u++) {
      size_t ro = (size_t)rw_row(d, b, 64 * c + 16 * q + u) * 256 + col;
      rkk[u] = scan[2 * ARR + ro];
      rbb[u] = scan[(size_t)(5 + 3 * d) * ARR + ro];
      rkd[u] = scan[(size_t)(4 + 3 * d) * ARR + ro];
      rvv[u] = scan[1 * ARR + ro];
      rrr[u] = MODE == 1 ? scan[0 * ARR + ro] : (u16)0;
    }
    qs[q * 64 + k] = run;
    __syncthreads();
    float pre = 0.f, tot = 0.f;
#pragma unroll
    for (int qq = 0; qq < 4; qq++) { float x = qs[qq * 64 + k]; tot += x; if (qq < q) pre += x; }
    float L = pre;
#pragma unroll
    for (int u = 0; u < 16; u++) {
      const int tau = 16 * q + u;
      const float Lp = L;
      L += lam[u];
      const float kk = bf2f(rkk[u]), bb = bf2f(rbb[u]);
      const float kd = bf2f(rkd[u]);
      const u16 vraw = rvv[u];
      const float eL = fexp2(L);
      const u16 ah = f2bf(kk * fexp2(-Lp));
      x0[tau * LDT + k] = ah;
      AHT[k * LDT + tau] = ah;
      x1[tau * LDT + k] = f2bf(bb * eL);
      x2[tau * LDT + k] = f2bf(kd * eL);
      x3[k * LDT + tau] = vraw;
      if (MODE == 0) {
        const float eC = fexp2(L - tot);
        x4[k * LDT + tau] = f2bf(bb * eC);
        x5[k * LDT + tau] = f2bf(kd * eC);
      } else {
        const float rr = bf2f(rrr[u]);
        x4[tau * LDT + k] = f2bf(rr * fexp2(-L));
      }
    }
    if (MODE == 0 && q == 0) wc[k] = fexp2(-tot);
    __syncthreads();
  }
  {
    f16 a_ab, a_ak, a_rb, a_rk;
    zero16(a_ab); zero16(a_ak); zero16(a_rb); zero16(a_rk);
    mm64<false>(a_ab, x0, x1, tm, tn, r, hh);
    mm64<false>(a_ak, x0, x2, tm, tn, r, hh);
    if (MODE == 1) {
      mm64<false>(a_rb, x4, x1, tm, tn, r, hh);
      mm64<false>(a_rk, x4, x2, tm, tn, r, hh);
    }
    __syncthreads();
#pragma unroll
    for (int i = 0; i < 16; i++) {
      int row = 32 * tm + (i & 3) + 8 * (i >> 2) + 4 * hh, col = 32 * tn + r;
      if ((row >> 4) == (col >> 4)) dg[(row >> 4) * 256 + (row & 15) * 16 + (col & 15)] = row > col ? a_ab[i] : 0.f;
    }
    put_tile_T<3>(LTN, a_ab, tm, tn, r, hh);
    put_tile<1>(x1, a_ak, tm, tn, r, hh);
    if (MODE == 1) { put_tile<2>(x2, a_rb, tm, tn, r, hh); put_tile<2>(x7, a_rk, tm, tn, r, hh); }
    __syncthreads();
  }
  {
    f16 a;
    zero16(a);
    mm64<false>(a, x1, x3, tm, tn, r, hh);
    float X[16];
    const int cc = lane & 15, gq = lane >> 4;
#pragma unroll
    for (int t = 0; t < 16; t++) {
      float acc = t == cc ? 1.f : 0.f;
#pragma unroll
      for (int j = 0; j < t; j++) acc -= dg[w * 256 + t * 16 + j] * X[j];
      X[t] = acc;
    }
    __syncthreads();
    put_tile_T<0>(x0, a, tm, tn, r, hh);
#pragma unroll
    for (int t = 0; t < 16; t++) TD[(16 * w + t) * LDT + 16 * gq + cc] = f2bf(gq == w ? X[t] : 0.f);
    __syncthreads();
  }
  {
    f16 n;
    zero16(n);
    mm64<false>(n, TD, LTN, tm, tn, r, hh);
    __syncthreads();
    put_tile<0>(LTN, n, tm, tn, r, hh);
    __syncthreads();
  }
  {
    f16 z0p, z0q;
    zero16(z0p); zero16(z0q);
    mm64<false>(z0p, TD, AHT, tm, tn, r, hh);
    mm64<false>(z0q, TD, x0, tm, tn, r, hh);
    __syncthreads();
    put_tile_T<0>(AHT, z0p, tm, tn, r, hh);
    put_tile_T<0>(x0, z0q, tm, tn, r, hh);
    __syncthreads();
#pragma unroll 1
    for (int itn = 0; itn < 3; itn++) {
      f16 np_, nq_;
      zero16(np_); zero16(nq_);
      mm64<false>(np_, LTN, AHT, tm, tn, r, hh);
      mm64<false>(nq_, LTN, x0, tm, tn, r, hh);
#pragma unroll
      for (int i = 0; i < 16; i++) { np_[i] = z0p[i] - np_[i]; nq_[i] = z0q[i] - nq_[i]; }
      __syncthreads();
      put_tile_T<0>(AHT, np_, tm, tn, r, hh);
      put_tile_T<0>(x0, nq_, tm, tn, r, hh);
      __syncthreads();
    }
  }
  if (MODE == 0) {
    f16 g;
    zero16(g);
    mm64<false>(g, x4, AHT, tm, tn, r, hh);
    u16* GT = (u16*)cbase;
#pragma unroll
    for (int i = 0; i < 16; i++) {
      int row = 32 * tm + (i & 3) + 8 * (i >> 2) + 4 * hh, col = 32 * tn + r;
      float v = (row == col ? wc[row] : 0.f) - g[i];
      GT[row * 64 + col] = f2bf(v);
    }
    f16 h1, h2;
    zero16(h1); zero16(h2);
    mm64<true>(h1, x5, x3, tm, tn, r, hh);
    mm64<true>(h2, x4, x0, tm, tn, r, hh);
    unsigned* HM = (unsigned*)(cbase + 8192) + (tm * 2 + tn) * 512;
#pragma unroll
    for (int q = 0; q < 8; q++) HM[q * 64 + lane] = pk2(h1[2 * q] - h2[2 * q], h1[2 * q + 1] - h2[2 * q + 1]);
    __syncthreads();
  } else {
    f16 ry, y1, y2;
    zero16(ry); zero16(y1); zero16(y2);
    mm64<false>(ry, x2, AHT, tm, tn, r, hh);
    mm64<false>(y1, x7, x3, tm, tn, r, hh);
    mm64<false>(y2, x2, x0, tm, tn, r, hh);
#pragma unroll
    for (int i = 0; i < 16; i++) {
      int row = 32 * tm + (i & 3) + 8 * (i >> 2) + 4 * hh, col = 32 * tn + r;
      x4[row * LDT + col] = f2bf(bf2f(x4[row * LDT + col]) - ry[i]);
      y1[i] -= y2[i];
    }
    __syncthreads();
    const unsigned char* S0 = cbase + 8192;
#pragma unroll
    for (int s = 0; s < 4; s++) {
      bf8 a = *(const bf8*)(x4 + (32 * tm + r) * LDT + 16 * s + 8 * hh);
      u4 bq = *(const u4*)(S0 + ((s >> 1) * 2 + tn) * 2048 + (s & 1) * 1024 + lane * 16);
      y1 = __builtin_amdgcn_mfma_f32_32x32x16_bf16(a, __builtin_bit_cast(bf8, bq), y1, 0, 0, 0);
    }
    yout = y1;
    __syncthreads();
  }
}

__device__ __forceinline__ void rwkv_s1_item(const Params& p, int item, u16* sm) {
  const int c = item % 260, chain = item / 260;
  f16 dummy;
  rwkv_chunk<0>(p, chain >> 3, (chain >> 1) & 3, chain & 1, c, sm, dummy);
}

__device__ __forceinline__ void rwkv_s2_item(const Params& p, int item) {
  const int tid = ltid(), lane = tid & 63, w = __builtin_amdgcn_readfirstlane(tid >> 6), r = lane & 31, hh = lane >> 5;
  const int chain = item * 2 + (w >> 1), vt = w & 1;
  unsigned char* base = p.ws + OFF_CB + (size_t)chain * 260 * 16384;
  f16 acc[2];
  zero16(acc[0]); zero16(acc[1]);
  u4 g[2][4]; unsigned hm[2][8];
  const int goff = (swz23(r) * 64 + 8 * hh) * 2;
#pragma unroll
  for (int kt = 0; kt < 2; kt++) {
#pragma unroll
    for (int s = 0; s < 4; s++) g[kt][s] = *(const u4*)(base + goff + kt * 32 * 128 + s * 32);
#pragma unroll
    for (int q = 0; q < 8; q++) hm[kt][q] = *(const unsigned*)(base + 8192 + (((kt * 2 + vt) * 8 + q) * 64 + lane) * 4);
  }
  for (int c = 0; c < 260; c++) {
    u4 gn[2][4]; unsigned hn[2][8];
    unsigned char* cb = base + (size_t)c * 16384;
    {
      const unsigned char* nb = base + (size_t)(c + 1 < 260 ? c + 1 : c) * 16384;
#pragma unroll
      for (int kt = 0; kt < 2; kt++) {
#pragma unroll
        for (int s = 0; s < 4; s++) gn[kt][s] = *(const u4*)(nb + goff + kt * 32 * 128 + s * 32);
#pragma unroll
        for (int q = 0; q < 8; q++) hn[kt][q] = *(const unsigned*)(nb + 8192 + (((kt * 2 + vt) * 8 + q) * 64 + lane) * 4);
      }
    }
    u4 bfg[4];
#pragma unroll
    for (int kt = 0; kt < 2; kt++)
#pragma unroll
      for (int s2 = 0; s2 < 2; s2++)
#pragma unroll
        for (int q = 0; q < 4; q++) bfg[2 * kt + s2][q] = pk2(acc[kt][8 * s2 + 2 * q], acc[kt][8 * s2 + 2 * q + 1]);
#pragma unroll
    for (int s = 0; s < 4; s++) *(u4*)(cb + 8192 + ((s >> 1) * 2 + vt) * 2048 + (s & 1) * 1024 + lane * 16) = bfg[s];
#pragma unroll
    for (int kt = 0; kt < 2; kt++) {
      f16 a;
#pragma unroll
      for (int q = 0; q < 8; q++) { a[2 * q] = lo16(hm[kt][q]); a[2 * q + 1] = hi16(hm[kt][q]); }
#pragma unroll
      for (int s = 0; s < 4; s++)
        a = __builtin_amdgcn_mfma_f32_32x32x16_bf16(__builtin_bit_cast(bf8, g[kt][s]), __builtin_bit_cast(bf8, bfg[s]), a, 0, 0, 0);
      acc[kt] = a;
    }
#pragma unroll
    for (int kt = 0; kt < 2; kt++) {
#pragma unroll
      for (int s = 0; s < 4; s++) g[kt][s] = gn[kt][s];
#pragma unroll
      for (int q = 0; q < 8; q++) hm[kt][q] = hn[kt][q];
    }
  }
}

__device__ __forceinline__ float qsum(float x) {
  x += __builtin_bit_cast(float, __builtin_amdgcn_update_dpp(0, __builtin_bit_cast(int, x), 0xB1, 0xF, 0xF, true));
  x += __builtin_bit_cast(float, __builtin_amdgcn_update_dpp(0, __builtin_bit_cast(int, x), 0x4E, 0xF, 0xF, true));
  return x;
}
__device__ __forceinline__ void rwkv_s3_item(const Params& p, int l, int item, u16* sm) {
  const int tid = ltid(), lane = tid & 63, w = __builtin_amdgcn_readfirstlane(tid >> 6), r = lane & 31, hh = lane >> 5;
  const int tm = w >> 1, tn = w & 1;
  const int tc = item % 260, bh = item / 260, b = bh >> 2, h = bh & 3;
  f16 yf, yb;
  zero16(yf); zero16(yb);
  for (int d = 0; d < 2; d++) {
    const int c = d == 0 ? tc : (tc < 4 ? 3 - tc : 263 - tc);
    f16 y;
    rwkv_chunk<1>(p, b, h, d, c, sm, y);
    if (d == 0) yf = y; else yb = y;
  }
  float* Ys = (float*)sm;
#pragma unroll
  for (int i = 0; i < 16; i++) {
    int row = 32 * tm + (i & 3) + 8 * (i >> 2) + 4 * hh;
    Ys[row * MABS + 32 * tn + r] = yf[i];
  }
  __syncthreads();
#pragma unroll
  for (int i = 0; i < 16; i++) {
    int row = 63 - (32 * tm + (i & 3) + 8 * (i >> 2) + 4 * hh);
    Ys[row * MABS + 32 * tn + r] += yb[i];
  }
  __syncthreads();
  {
    const int tok = tid >> 2, q4 = tid & 3;
    const size_t ro = (size_t)(b * TT + 64 * tc + tok) * 256 + h * 64 + 16 * q4;
    const u16* scan = (const u16*)(p.ws + OFF_SCAN);
    u16* GB = (u16*)(p.ws + OFF_GB);
    float y[16], sum = 0.f, sq = 0.f;
#pragma unroll
    for (int i = 0; i < 4; i++) {
      f4 v4 = *(const f4*)(Ys + tok * MABS + 16 * q4 + 4 * i);
#pragma unroll
      for (int j = 0; j < 4; j++) { y[4 * i + j] = v4[j]; sum += v4[j]; sq += v4[j] * v4[j]; }
    }
    sum = qsum(sum); sq = qsum(sq);
    const float mean = sum * (1.f / 64.f);
    const float var = fmaxf(sq * (1.f / 64.f) - mean * mean, 0.f);
    const float rstd = rsqrtf(var + 64e-5f);
    float rr[16], kf[16], kb[16], vv[16], gg[16];
    auto ld16 = [&](const u16* src, float* dst) {
      u4 a = *(const u4*)src, c2 = *(const u4*)(src + 8);
#pragma unroll
      for (int e = 0; e < 4; e++) { dst[2 * e] = lo16(a[e]); dst[2 * e + 1] = hi16(a[e]); dst[8 + 2 * e] = lo16(c2[e]); dst[8 + 2 * e + 1] = hi16(c2[e]); }
    };
    ld16(scan + 0 * ARR + ro, rr); ld16(scan + 4 * ARR + ro, kf); ld16(scan + 7 * ARR + ro, kb);
    ld16(scan + 1 * ARR + ro, vv); ld16(GB + ro, gg);
    const float* rk = p.rrk + l * 256 + h * 64 + 16 * q4;
    const float* lg = p.lnx_g + l * 256 + h * 64 + 16 * q4;
    const float* lb = p.lnx_b + l * 256 + h * 64 + 16 * q4;
    float bonus = 0.f;
#pragma unroll
    for (int i = 0; i < 16; i++) bonus += rr[i] * (kf[i] + kb[i]) * rk[i];
    bonus = qsum(bonus);
    float o[16];
#pragma unroll
    for (int i = 0; i < 16; i++) o[i] = ((y[i] - mean) * rstd * lg[i] + lb[i] + bonus * vv[i]) * gg[i];
    store8(GB + ro, o);
    store8(GB + ro + 8, o + 8);
  }
  __syncthreads();
}

template <int MODE>
__device__ __forceinline__ void attn_item(const Params& p, int l, int item, u16* sm) {
  constexpr int NS = MODE == 0 ? 2 : 4;
  const int tid = ltid(), lane = tid & 63, w = __builtin_amdgcn_readfirstlane(tid >> 6), r = lane & 31, hh = lane >> 5;
  const int pl = w >> 1, rb = w & 1;
  u16* ACD = (u16*)(p.ws + OFF_ACD);
  int b, hd, qrow0, ntile, jlo = 0, qb = 0;
  bool latent;
  if (MODE == 0) {
    if (item < 2048) { b = item >> 10; hd = (item >> 8) & 3; qb = item & 255; qrow0 = b * TT + CTX + 64 * qb; ntile = 260; latent = true; }
    else { int j = item - 2048; b = j >> 4; hd = (j >> 2) & 3; qrow0 = b * TT + 64 * (j & 3); ntile = 4; latent = false; }
  } else {
    if (item < 1024) {
      b = item >> 9; hd = (item >> 8) & 1; qb = item & 255; qrow0 = b * TT + CTX + 64 * qb; latent = true;
      jlo = qb - 2; if (jlo < 0) jlo = 0;
      int jhi = qb + 3; if (jhi > 256) jhi = 256;
      ntile = 4 + (jhi - jlo);
    } else { int j = item - 1024; b = j >> 3; hd = (j >> 2) & 1; qrow0 = b * TT + 64 * (j & 3); ntile = 4; latent = false; }
  }
  const int kcol = MODE == 0 ? 256 + hd * 64 : 1792 + hd * 64;
  const int vcol = MODE == 0 ? 512 + hd * 64 : 1920 + hd * 64;
  const int qcol = MODE == 0 ? hd * 64 + 32 * pl : 1536 + hd * 128 + 64 * pl;
  const int koff = MODE == 0 ? 32 * pl : 0;
  const size_t qrow = (size_t)qrow0 + 32 * rb + r;
  bf8 qf[NS];
#pragma unroll
  for (int s = 0; s < NS; s++) qf[s] = *(const bf8*)(ACD + qrow * PACD + qcol + 16 * s + 8 * hh);
  f16 O[2], negm, lacc;
  float m = 0.f;
#pragma unroll
  for (int i = 0; i < 16; i++) { O[0][i] = 0.f; O[1][i] = 0.f; negm[i] = 0.f; lacc[i] = 0.f; }
  u4 ones_u; ones_u[0] = ones_u[1] = ones_u[2] = ones_u[3] = 0x3F803F80u;
  const bf8 ones = __builtin_bit_cast(bf8, ones_u);
  auto keyrow0 = [&](int kt) -> size_t {
    if (MODE == 0 || kt < 4) return (size_t)b * TT + 64 * kt;
    return (size_t)b * TT + CTX + 64 * (jlo + kt - 4);
  };
  u4 rkA[2], rvA[2], rkB[2], rvB[2];
  const int kr = tid >> 3, kc = (tid & 7) * 8;
  const int kp = tid >> 3, dg = tid & 7;
  auto gload = [&](u4 (&rk)[2], u4 (&rv)[2], int kt) {
    const size_t k0 = keyrow0(kt);
    rk[0] = *(const u4*)(ACD + (k0 + kr) * PACD + kcol + kc);
    rk[1] = *(const u4*)(ACD + (k0 + kr + 32) * PACD + kcol + kc);
    rv[0] = *(const u4*)(ACD + (k0 + 2 * kp) * PACD + vcol + dg * 8);
    rv[1] = *(const u4*)(ACD + (k0 + 2 * kp + 1) * PACD + vcol + dg * 8);
  };
  auto swrite = [&](const u4 (&rk)[2], const u4 (&rv)[2], int buf) {
    u16* Kb = sm + buf * 2 * 64 * LDT;
    u16* Vb = Kb + 64 * LDT;
    *(u4*)(Kb + kr * LDT + kc) = rk[0];
    *(u4*)(Kb + (kr + 32) * LDT + kc) = rk[1];
#pragma unroll
    for (int e = 0; e < 4; e++) {
      unsigned a = rv[0][e], c2 = rv[1][e];
      *(unsigned*)(Vb + (dg * 8 + 2 * e) * LDT + 2 * kp) = (a & 0xffffu) | (c2 << 16);
      *(unsigned*)(Vb + (dg * 8 + 2 * e + 1) * LDT + 2 * kp) = (a >> 16) | (c2 & 0xffff0000u);
    }
  };
  gload(rkA, rvA, 0);
  gload(rkB, rvB, 1);
  swrite(rkA, rvA, 0);
  __syncthreads();
  const int qlo = 64 * qb + 32 * rb;
  const int qpos = qlo + r;
  auto tile_body = [&](int kt, u4 (&rkL)[2], u4 (&rvL)[2], u4 (&rkW)[2], u4 (&rvW)[2]) {
    if (kt + 2 < ntile) gload(rkL, rvL, kt + 2);
    const u16* Kb = sm + (kt & 1) * 2 * 64 * LDT;
    const u16* Vb = Kb + 64 * LDT;
    bool skip = false;
    int kpos0 = 0;
    const bool masked = (MODE == 1) && latent && kt >= 4;
    if (masked) {
      kpos0 = 64 * (jlo + kt - 4);
      if (kpos0 > qlo + 31 + 128 || kpos0 + 63 < qlo - 128) skip = true;
    }
    if (!skip) {
      u4 pb[2][2];
      f16 st[2];
#pragma unroll
      for (int kb = 0; kb < 2; kb++) {
        st[kb] = negm;
#pragma unroll
        for (int s = 0; s < NS; s++) {
          bf8 a = *(const bf8*)(Kb + (32 * kb + swz23(r)) * LDT + koff + 16 * s + 8 * hh);
          st[kb] = __builtin_amdgcn_mfma_f32_32x32x16_bf16(a, qf[s], st[kb], 0, 0, 0);
        }
      }
      if (masked) {
#pragma unroll
        for (int kb = 0; kb < 2; kb++)
#pragma unroll
          for (int i = 0; i < 16; i++) {
            int kpos = kpos0 + 32 * kb + (i & 7) + 8 * hh + 16 * (i >> 3);
            int dd = qpos - kpos;
            if (dd > 128 || dd < -128) st[kb][i] = -1e30f;
          }
      }
      float mt = st[0][0];
#pragma unroll
      for (int i = 1; i < 16; i++) mt = fmaxf(mt, st[0][i]);
#pragma unroll
      for (int i = 0; i < 16; i++) mt = fmaxf(mt, st[1][i]);
      mt = xhalf_max(mt);
      const bool first = kt == 0;
      if (first || __any(mt > 8.f)) {
        const float dm = first ? mt : fmaxf(mt, 0.f);
        const float al = first ? 1.f : fexp2(-dm);
        m += dm;
        lacc[0] *= al;
#pragma unroll
        for (int i = 0; i < 16; i++) { O[0][i] *= al; O[1][i] *= al; st[0][i] -= dm; st[1][i] -= dm; negm[i] = -m; }
      }
#pragma unroll
      for (int kb = 0; kb < 2; kb++) {
#pragma unroll
        for (int i = 0; i < 16; i++) st[kb][i] = fexp2(st[kb][i]);
#pragma unroll
        for (int s = 0; s < 2; s++)
#pragma unroll
          for (int q = 0; q < 4; q++) pb[kb][s][q] = pk2(st[kb][8 * s + 2 * q], st[kb][8 * s + 2 * q + 1]);
      }
#pragma unroll
      for (int kb = 0; kb < 2; kb++)
#pragma unroll
        for (int s = 0; s < 2; s++)
          lacc = __builtin_amdgcn_mfma_f32_32x32x16_bf16(ones, __builtin_bit_cast(bf8, pb[kb][s]), lacc, 0, 0, 0);
#pragma unroll
      for (int dt = 0; dt < 2; dt++)
#pragma unroll
        for (int kb = 0; kb < 2; kb++)
#pragma unroll
          for (int s = 0; s < 2; s++) {
            bf8 a = *(const bf8*)(Vb + (32 * dt + r) * LDT + 32 * kb + 16 * s + 8 * hh);
            O[dt] = __builtin_amdgcn_mfma_f32_32x32x16_bf16(a, __builtin_bit_cast(bf8, pb[kb][s]), O[dt], 0, 0, 0);
          }
    }
    if (kt + 1 < ntile) swrite(rkW, rvW, (kt + 1) & 1);
    __syncthreads();
  };
  for (int kt = 0; kt < ntile; kt += 2) {
    tile_body(kt, rkA, rvA, rkB, rvB);
    if (kt + 1 < ntile) tile_body(kt + 1, rkB, rvB, rkA, rvA);
  }
  if (MODE == 0) {
    const float lam_init = 0.8f - 0.6f * __expf(-0.3f * (float)l);
    float d0 = 0.f, d1 = 0.f;
    for (int i = 0; i < 32; i++) {
      d0 += p.lam_q[(l * 2 + 0) * 32 + i] * p.lam_k[(l * 2 + 0) * 32 + i];
      d1 += p.lam_q[(l * 2 + 1) * 32 + i] * p.lam_k[(l * 2 + 1) * 32 + i];
    }
    const float lam = __expf(d0) - __expf(d1) + lam_init;
    const float inv = (pl == 0 ? 1.f : lam) / lacc[0];
    float* xch = (float*)sm + rb * (32 * 64);
    if (pl == 1) {
#pragma unroll
      for (int dt = 0; dt < 2; dt++)
#pragma unroll
        for (int i = 0; i < 16; i++) xch[(dt * 16 + i) * 64 + lane] = O[dt][i] * inv;
    }
    __syncthreads();
    if (pl == 0) {
      float ss = 0.f;
#pragma unroll
      for (int dt = 0; dt < 2; dt++)
#pragma unroll
        for (int i = 0; i < 16; i++) { float o = O[dt][i] * inv - xch[(dt * 16 + i) * 64 + lane]; O[dt][i] = o; ss += o * o; }
      ss = xhalf_sum(ss);
      const float rs = rsqrtf(ss * (1.f / 64.f) + 1e-5f) * (1.f - lam_init);
      const float* gs = p.subln + l * 256 + hd * 64;
#pragma unroll
      for (int dt = 0; dt < 2; dt++)
#pragma unroll
        for (int i4 = 0; i4 < 4; i4++) {
          const int dv = 32 * dt + 8 * i4 + 4 * hh;
          u2 ov;
          ov[0] = pk2(O[dt][4 * i4 + 0] * rs * gs[dv + 0], O[dt][4 * i4 + 1] * rs * gs[dv + 1]);
          ov[1] = pk2(O[dt][4 * i4 + 2] * rs * gs[dv + 2], O[dt][4 * i4 + 3] * rs * gs[dv + 3]);
          *(u2*)(ACD + qrow * PACD + hd * 64 + dv) = ov;
        }
    }
    __syncthreads();
  } else {
    const float sk = p.win_sink[l * 4 + hd * 2 + pl] * LOG2E;
    const float lt = lacc[0] + fexp2(sk - m);
    const float inv = 1.f / lt;
#pragma unroll
    for (int dt = 0; dt < 2; dt++)
#pragma unroll
      for (int i4 = 0; i4 < 4; i4++) {
        const int dv = 32 * dt + 8 * i4 + 4 * hh;
        u2 ov;
        ov[0] = pk2(O[dt][4 * i4 + 0] * inv, O[dt][4 * i4 + 1] * inv);
        ov[1] = pk2(O[dt][4 * i4 + 2] * inv, O[dt][4 * i4 + 3] * inv);
        *(u2*)(ACD + qrow * PACD + 1536 + (hd * 2 + pl) * 64 + dv) = ov;
      }
  }
}

__device__ __forceinline__ void attnA2_item(const Params& p, int l, int item, u16* sm) {
  const int tid = ltid(), lane = tid & 63, w = __builtin_amdgcn_readfirstlane(tid >> 6), r = lane & 31, hh = lane >> 5;
  u16* ACD = (u16*)(p.ws + OFF_ACD);
  int b, hd, qrow0, ntile;
  if (item < 1024) { b = item >> 9; hd = (item >> 7) & 3; qrow0 = b * TT + CTX + 128 * (item & 127); ntile = 260; }
  else { int j = item - 1024; b = j >> 3; hd = (j >> 1) & 3; qrow0 = b * TT + 128 * (j & 1); ntile = 4; }
  const int kcol = 256 + hd * 64, vcol = 512 + hd * 64;
  const size_t qrow = (size_t)qrow0 + 32 * w + r;
  bf8 qf[2][2];
#pragma unroll
  for (int pl = 0; pl < 2; pl++)
#pragma unroll
    for (int s = 0; s < 2; s++) qf[pl][s] = *(const bf8*)(ACD + qrow * PACD + hd * 64 + 32 * pl + 16 * s + 8 * hh);
  f16 O[2][2];
  float m[2] = {0.f, 0.f}, lsum[2] = {0.f, 0.f};
#pragma unroll
  for (int pl = 0; pl < 2; pl++)
#pragma unroll
    for (int dt = 0; dt < 2; dt++)
#pragma unroll
      for (int i = 0; i < 16; i++) O[pl][dt][i] = 0.f;
  u4 rkA[2], rvA[2], rkB[2], rvB[2];
  const int kr = tid >> 3, kc = (tid & 7) * 8;
  const int kp = tid >> 3, dg = tid & 7;
  auto gload = [&](u4 (&rk)[2], u4 (&rv)[2], int kt) {
    const size_t k0 = (size_t)b * TT + 64 * kt;
    rk[0] = *(const u4*)(ACD + (k0 + kr) * PACD + kcol + kc);
    rk[1] = *(const u4*)(ACD + (k0 + kr + 32) * PACD + kcol + kc);
    rv[0] = *(const u4*)(ACD + (k0 + 2 * kp) * PACD + vcol + dg * 8);
    rv[1] = *(const u4*)(ACD + (k0 + 2 * kp + 1) * PACD + vcol + dg * 8);
  };
  auto swrite = [&](const u4 (&rk)[2], const u4 (&rv)[2], int buf) {
    u16* Kb = sm + buf * 2 * 64 * LDT;
    u16* Vb = Kb + 64 * LDT;
    *(u4*)(Kb + kr * LDT + kc) = rk[0];
    *(u4*)(Kb + (kr + 32) * LDT + kc) = rk[1];
#pragma unroll
    for (int e = 0; e < 4; e++) {
      unsigned a = rv[0][e], c2 = rv[1][e];
      *(unsigned*)(Vb + (dg * 8 + 2 * e) * LDT + 2 * kp) = (a & 0xffffu) | (c2 << 16);
      *(unsigned*)(Vb + (dg * 8 + 2 * e + 1) * LDT + 2 * kp) = (a >> 16) | (c2 & 0xffff0000u);
    }
  };
  gload(rkA, rvA, 0);
  gload(rkB, rvB, 1);
  swrite(rkA, rvA, 0);
  __syncthreads();
  auto tile_body = [&](int kt, u4 (&rkL)[2], u4 (&rvL)[2], u4 (&rkW)[2], u4 (&rvW)[2]) {
    if (kt + 2 < ntile) gload(rkL, rvL, kt + 2);
    const u16* Kb = sm + (kt & 1) * 2 * 64 * LDT;
    const u16* Vb = Kb + 64 * LDT;
    const bool first = kt == 0;
#pragma unroll
    for (int pl = 0; pl < 2; pl++) {
      u4 pb[2][2];
      f16 st[2];
#pragma unroll
      for (int kb = 0; kb < 2; kb++) {
#pragma unroll
        for (int i = 0; i < 16; i++) st[kb][i] = 0.f;
#pragma unroll
        for (int s = 0; s < 2; s++) {
          bf8 a = *(const bf8*)(Kb + (32 * kb + swz23(r)) * LDT + 32 * pl + 16 * s + 8 * hh);
          st[kb] = __builtin_amdgcn_mfma_f32_32x32x16_bf16(a, qf[pl][s], st[kb], 0, 0, 0);
        }
      }
      float mt = st[0][0];
#pragma unroll
      for (int i = 1; i < 16; i++) mt = fmaxf(mt, st[0][i]);
#pragma unroll
      for (int i = 0; i < 16; i++) mt = fmaxf(mt, st[1][i]);
      mt = xhalf_max(mt);
      if (first || __any(mt > m[pl] + 8.f)) {
        const float mn = first ? mt : fmaxf(m[pl], mt);
        const float al = first ? 1.f : fexp2(m[pl] - mn);
        m[pl] = mn; lsum[pl] *= al;
#pragma unroll
        for (int i = 0; i < 16; i++) { O[pl][0][i] *= al; O[pl][1][i] *= al; }
      }
      const float mm = m[pl];
      float ls = 0.f;
#pragma unroll
      for (int kb = 0; kb < 2; kb++) {
#pragma unroll
        for (int i = 0; i < 16; i++) { float e = fexp2(st[kb][i] - mm); st[kb][i] = e; ls += e; }
#pragma unroll
        for (int s = 0; s < 2; s++)
#pragma unroll
          for (int q = 0; q < 4; q++) pb[kb][s][q] = pk2(st[kb][8 * s + 2 * q], st[kb][8 * s + 2 * q + 1]);
      }
      lsum[pl] += ls;
#pragma unroll
      for (int dt = 0; dt < 2; dt++)
#pragma unroll
        for (int kb = 0; kb < 2; kb++)
#pragma unroll
          for (int s = 0; s < 2; s++) {
            bf8 a = *(const bf8*)(Vb + (32 * dt + r) * LDT + 32 * kb + 16 * s + 8 * hh);
            O[pl][dt] = __builtin_amdgcn_mfma_f32_32x32x16_bf16(a, __builtin_bit_cast(bf8, pb[kb][s]), O[pl][dt], 0, 0, 0);
          }
      __builtin_amdgcn_sched_barrier(0);
    }
    if (kt + 1 < ntile) swrite(rkW, rvW, (kt + 1) & 1);
    __syncthreads();
  };
  for (int kt = 0; kt < ntile; kt += 2) {
    tile_body(kt, rkA, rvA, rkB, rvB);
    tile_body(kt + 1, rkB, rvB, rkA, rvA);
  }
  const float lam_init = 0.8f - 0.6f * __expf(-0.3f * (float)l);
  float d0 = 0.f, d1 = 0.f;
  for (int i = 0; i < 32; i++) {
    d0 += p.lam_q[(l * 2 + 0) * 32 + i] * p.lam_k[(l * 2 + 0) * 32 + i];
    d1 += p.lam_q[(l * 2 + 1) * 32 + i] * p.lam_k[(l * 2 + 1) * 32 + i];
  }
  const float lam = __expf(d0) - __expf(d1) + lam_init;
  const float i0 = 1.f / xhalf_sum(lsum[0]);
  const float i1 = lam / xhalf_sum(lsum[1]);
  float ss = 0.f;
#pragma unroll
  for (int dt = 0; dt < 2; dt++)
#pragma unroll
    for (int i = 0; i < 16; i++) { float o = O[0][dt][i] * i0 - O[1][dt][i] * i1; O[0][dt][i] = o; ss += o * o; }
  ss = xhalf_sum(ss);
  const float rs = rsqrtf(ss * (1.f / 64.f) + 1e-5f) * (1.f - lam_init);
  const float* gs = p.subln + l * 256 + hd * 64;
#pragma unroll
  for (int dt = 0; dt < 2; dt++)
#pragma unroll
    for (int i4 = 0; i4 < 4; i4++) {
      const int dv = 32 * dt + 8 * i4 + 4 * hh;
      u2 ov;
      ov[0] = pk2(O[0][dt][4 * i4 + 0] * rs * gs[dv + 0], O[0][dt][4 * i4 + 1] * rs * gs[dv + 1]);
      ov[1] = pk2(O[0][dt][4 * i4 + 2] * rs * gs[dv + 2], O[0][dt][4 * i4 + 3] * rs * gs[dv + 3]);
      *(u2*)(ACD + qrow * PACD + hd * 64 + dv) = ov;
    }
}

__device__ __forceinline__ void phase_m1(const Params& p, int l, unsigned char* smem) {
  const int NP = NR / 16, NC = 260 * 4;
  for (int it = blockIdx.x; it < NP + NC; it += gridDim.x) {
    if (it < NP) prepb_tile(p, l, it, (float*)smem);
    else retc1_item(p, l, it - NP, (float*)smem);
  }
}
__device__ __forceinline__ unsigned xb_xcc_id();
__device__ __forceinline__ void phase_m2(const Params& p, int l, unsigned char* smem) {
  __shared__ int s_item;
  unsigned* ctr = (unsigned*)(p.ws + OFF_CTR) + 16 * l;
  const int N0 = 4160, N1 = N0 + 1040, N2 = N1 + 128;
  for (;;) {
    if (threadIdx.x == 0) s_item = (int)atomicAdd(ctr, 1u);
    __syncthreads();
    const int it = s_item;
    __syncthreads();
    if (it >= N2) break;
    if (it < N0) rwkv_s1_item(p, it, (u16*)smem);
    else if (it < N1) attn_item<1>(p, l, it - N0, (u16*)smem);
    else retc2_item(p, l, it - N1);
  }
}
__device__ __forceinline__ void phase_m2b(const Params& p, int l, unsigned char* smem) {
  __shared__ int s_item2;
  unsigned* ctr = (unsigned*)(p.ws + OFF_CTR) + 16 * l;
  for (;;) {
    if (threadIdx.x == 0) s_item2 = (int)atomicAdd(ctr + 1, 1u);
    __syncthreads();
    const int it = s_item2;
    __syncthreads();
    if (it >= 8) break;
    rwkv_s2_item(p, it);
  }
  const int x0 = (int)(xb_xcc_id() & 7u);
  for (int dx = 0; dx < 8; dx++) {
    const int x = (x0 + dx) & 7;
    for (;;) {
      if (threadIdx.x == 0) s_item2 = (int)atomicAdd(ctr + 2 + x, 1u);
      __syncthreads();
      const int j = s_item2;
      __syncthreads();
      if (j >= 130) break;
      attnA2_item(p, l, j < 128 ? x * 128 + j : 1024 + x * 2 + (j - 128), (u16*)smem);
    }
  }
}
__device__ __forceinline__ void phase_m3(const Params& p, int l, unsigned char* smem) {
  const int NF = 2080, NC = 260 * 4;
  for (int it = blockIdx.x; it < NF + NC; it += gridDim.x) {
    if (it < NF) rwkv_s3_item(p, l, it, (u16*)smem);
    else retc3_item(p, l, it - NF, (u16*)smem);
  }
}

__device__ __forceinline__ void phase_merge(const Params& p, int l, unsigned char* smem) {
  const u16* H = (const u16*)(p.ws + OFF_H);
  const u16* winT = (const u16*)(p.ws + OFF_WA);
  const u16* wbrT = winT + (size_t)WINC * DM;
  const u16* ACD = (const u16*)(p.ws + OFF_ACD);
  const u16* GB = (const u16*)(p.ws + OFF_GB);
  u16* M = (u16*)(p.ws + OFF_M);
  GemmPipe<1> pp;
  auto yptr = [&](int n, const u16*& yp, int& yl) {
    if (n == 0) { yp = ACD; yl = PACD; } else if (n == 1) { yp = GB; yl = 256; }
    else if (n == 2) { yp = ACD + 1280; yl = PACD; } else { yp = ACD + 1536; yl = PACD; }
  };
  int mt, nt;
  bool have = gemm_tile_of(0, 16, mt, nt);
  if (have) gemm_prefetch<1>(pp, H + (size_t)mt * 128 * DM, DM, winT + ((size_t)3200 + nt * 64) * DM, DM);
  for (int kk = 0; have; kk++) {
    const int m0 = mt * 128, n0 = nt * 64;
    have = gemm_tile_of(kk + 1, 16, mt, nt);
    f16 macc[2][1];
    zero_acc<1>(macc);
#pragma unroll 1
    for (int n = 0; n < 4; n++) {
      const u16* yp; int yl;
      yptr(n, yp, yl);
      f16 gacc[2][1];
      zero_acc<1>(gacc);
      gemm_main<1>(gacc, pp, H + (size_t)m0 * DM, DM, winT + ((size_t)3200 + n * DM + n0) * DM, DM, DM, (u16*)smem);
      gemm_prefetch<1>(pp, yp + (size_t)m0 * yl, yl, wbrT + ((size_t)n * DM + n0) * 256, 256);
      unsigned sg[2][8];
#pragma unroll
      for (int mi = 0; mi < 2; mi++)
#pragma unroll
        for (int i = 0; i < 8; i++) sg[mi][i] = pk2(fsigmoid(gacc[mi][0][2 * i]), fsigmoid(gacc[mi][0][2 * i + 1]));
      f16 yacc[2][1];
      zero_acc<1>(yacc);
      gemm_main<1>(yacc, pp, yp + (size_t)m0 * yl, yl, wbrT + ((size_t)n * DM + n0) * 256, 256, 256, (u16*)smem);
      {
        int m0n = m0, n0n = n0, nn = n + 1;
        bool hv = true;
        if (nn == 4) { hv = have; m0n = mt * 128; n0n = nt * 64; nn = 0; }
        if (hv) gemm_prefetch<1>(pp, H + (size_t)m0n * DM, DM, winT + ((size_t)3200 + nn * DM + n0n) * DM, DM);
      }
#pragma unroll
      for (int mi = 0; mi < 2; mi++)
#pragma unroll
        for (int i = 0; i < 8; i++) {
          macc[mi][0][2 * i] += lo16(sg[mi][i]) * yacc[mi][0][2 * i];
          macc[mi][0][2 * i + 1] += hi16(sg[mi][i]) * yacc[mi][0][2 * i + 1];
        }
    }
    gemm_epi<1>(macc, (float*)smem, [&](int row, int c8, const float* e) {
      store8(M + (size_t)(m0 + row) * DM + n0 + c8, e);
    });
  }
}

template <int ACT>
__device__ __forceinline__ void phase_gemm(const u16* A, const u16* WT, u16* OUT, int N, int K, unsigned char* smem) {
  const int ntn = N >> 7;
  GemmPipe<2> pp;
  int mt, nt;
  bool have = gemm_tile_of(0, ntn, mt, nt);
  if (have) gemm_prefetch<2>(pp, A + (size_t)mt * 128 * K, K, WT + (size_t)nt * 128 * K, K);
  for (int kk = 0; have; kk++) {
    const int m0 = mt * 128, n0 = nt * 128;
    f16 acc[2][2];
    zero_acc<2>(acc);
    gemm_main<2>(acc, pp, A + (size_t)m0 * K, K, WT + (size_t)n0 * K, K, K, (u16*)smem);
    have = gemm_tile_of(kk + 1, ntn, mt, nt);
    if (have) gemm_prefetch<2>(pp, A + (size_t)mt * 128 * K, K, WT + (size_t)nt * 128 * K, K);
    gemm_epi<2>(acc, (float*)smem, [&](int row, int c8, const float* e) {
      float v[8];
#pragma unroll
      for (int i = 0; i < 8; i++) { float x = e[i]; if (ACT == 1) { x = fmaxf(x, 0.f); x = x * x; } v[i] = x; }
      store8(OUT + (size_t)(m0 + row) * N + n0 + c8, v);
    });
  }
}

__device__ __forceinline__ unsigned xb_xcc_id() { return (unsigned)__builtin_amdgcn_s_getreg((3 << 11) | 20) & 0xFu; }

constexpr int PH_PER_LAYER = 11;
constexpr int NPHASE = 2 + DEPTH * PH_PER_LAYER;

__device__ __forceinline__ void run_phase(const Params& p, int ph, unsigned char* smem) {
  if (ph == 0) { phase_pro(p, smem); return; }
  if (ph == 1) { phase_rows(p, 0, 0); return; }
  const int l = (ph - 2) / PH_PER_LAYER, s = (ph - 2) % PH_PER_LAYER;
  unsigned char* ws = p.ws;
  switch (s) {
    case 0: phase_gemm1(p, l, smem); break;
    case 1: phase_m1(p, l, smem); break;
    case 2: phase_m2(p, l, smem); break;
    case 3: phase_m2b(p, l, smem); break;
    case 4: phase_m3(p, l, smem); break;
    case 5: phase_merge(p, l, smem); break;
    case 6: phase_gemm<0>((const u16*)(ws + OFF_M), (const u16*)(ws + OFF_WA) + (size_t)WINC * DM + (size_t)4 * DM * 256,
                          (u16*)(ws + OFF_MO), DM, DM, smem); break;
    case 7: phase_rows(p, l, 1); break;
    case 8: phase_gemm<1>((const u16*)(ws + OFF_H), (const u16*)(ws + OFF_WM), (u16*)(ws + OFF_U), DFF, DM, smem); break;
    case 9: phase_gemm<0>((const u16*)(ws + OFF_U), (const u16*)(ws + OFF_WM) + (size_t)DFF * DM, (u16*)(ws + OFF_DN), DM, DFF, smem); break;
    case 10: phase_rows(p, l, 2); if (l + 1 < DEPTH) wconv_layer(p, l + 1, smem); break;
  }
}

__global__ void __launch_bounds__(256, 2) mega_kernel(Params p) {
  __shared__ __attribute__((aligned(16))) unsigned char smem[SMEM_BYTES];
  cg::grid_group grid = cg::this_grid();
  for (int ph = 0; ph < NPHASE; ph++) {
    run_phase(p, ph, smem);
    if (ph + 1 < NPHASE) {
      grid.sync();
    }
  }
}

#if MULTI_LAUNCH
__global__ void __launch_bounds__(256, 2) phase_kernel(Params p, int ph) {
  __shared__ __attribute__((aligned(16))) unsigned char smem[SMEM_BYTES];
  run_phase(p, ph, smem);
}
#endif

extern "C" void kernel_launch(void* const* d_in, const int* in_sizes, int n_in, void* d_out, int out_size, void* d_ws,
                              size_t ws_size, hipStream_t stream) {
  Params p{};
  const float** pp = (const float**)&p;
  for (int i = 0; i < 32; i++) pp[i] = (const float*)d_in[i];
  p.out = (float*)d_out;
  p.ws = (unsigned char*)d_ws;
#if MULTI_LAUNCH
  hipMemsetAsync((unsigned char*)d_ws + OFF_CTR, 0, 256, stream);
  for (int ph = 0; ph < NPHASE; ph++) phase_kernel<<<dim3(512), dim3(256), 0, stream>>>(p, ph);
#else
  static int grid_blocks = 0;
  if (!grid_blocks) {
    int dev = 0, cus = 0, per_cu = 0;
    hipGetDevice(&dev);
    hipDeviceGetAttribute(&cus, hipDeviceAttributeMultiprocessorCount, dev);
    hipOccupancyMaxActiveBlocksPerMultiprocessor(&per_cu, mega_kernel, 256, 0);
    if (per_cu > 2) per_cu = 2;
    if (per_cu < 1) per_cu = 1;
    grid_blocks = cus * per_cu;
  }
  (void)hipMemsetAsync((unsigned char*)d_ws + OFF_CTR, 0, 4096, stream);
  void* args[] = {&p};
  hipError_t e = hipLaunchCooperativeKernel((void*)mega_kernel, dim3(grid_blocks), dim3(256), args, 0, stream);
  if (e != hipSuccess) fprintf(stderr, "cooperative launch failed: %s (grid %d)\n", hipGetErrorString(e), grid_blocks);
#endif
}
```

```cpp
#include <hip/hip_runtime.h>
#include <hip/hip_cooperative_groups.h>
#include <stdint.h>
#include <stdio.h>
namespace cg = cooperative_groups;

typedef unsigned short u16;
typedef __attribute__((ext_vector_type(8))) __bf16 bf8;
typedef __attribute__((ext_vector_type(2))) __bf16 bf2;
typedef __attribute__((ext_vector_type(2))) float f2;
typedef __attribute__((ext_vector_type(4))) float f4;
typedef __attribute__((ext_vector_type(16))) float f16;
typedef __attribute__((ext_vector_type(4))) unsigned u4;
typedef __attribute__((ext_vector_type(2))) unsigned u2;

#ifndef MULTI_LAUNCH
#define MULTI_LAUNCH 0
#endif

constexpr int DM = 1024, NB = 2, SEQ = 16384, CTX = 256, TT = SEQ + CTX, NR = NB * TT, DEPTH = 4;
constexpr int WINC = 7296, DFF = 4096;
constexpr int PACD = 2048, PCB = 1152;
constexpr size_t MiB = 1u << 20;
constexpr size_t OFF_CTXRES = 0, OFF_MOD = 2 * MiB, OFF_CTR = 2 * MiB + 512 * 1024, OFF_TAB = 3 * MiB, OFF_WA = 6 * MiB,
                 OFF_H = 25 * MiB, OFF_ACD = 90 * MiB, OFF_CB = 220 * MiB, OFF_SCAN = 294 * MiB, OFF_GB = 441 * MiB,
                 OFF_DS = 458 * MiB, OFF_SIN = 475 * MiB, OFF_WM = 484 * MiB,
                 OFF_M = OFF_SCAN, OFF_MO = OFF_CB, OFF_U = 90 * MiB, OFF_DN = 360 * MiB;
constexpr size_t ARR = (size_t)NR * 256;
constexpr float LOG2E = 1.4426950408889634f;
constexpr int LDT = 72;
constexpr int EPS = 132;
constexpr int SMEM_BYTES = 2 * 2 * 128 * LDT * 2 + 5376;

struct Params {
  const float *x, *c, *ctx, *c_ctx, *ada_w, *ada_b, *n_pre_mix, *n_post_mix, *n_pre_mlp, *n_post_mlp, *w_in,
      *lam_q, *lam_k, *subln, *mu, *w0, *w2, *a0, *a2, *g2, *rkk, *rka, *rrk, *lnx_g, *lnx_b, *ret_decay, *ret_gn,
      *win_sink, *w_branch, *w_out, *w_up, *w_down;
  float* out;
  unsigned char* ws;
};

__device__ __forceinline__ float bf2f(u16 h) { return __uint_as_float(((unsigned)h) << 16); }
__device__ __forceinline__ unsigned pk2(float a, float b) {
  bf2 r = __builtin_convertvector((f2){a, b}, bf2);
  return __builtin_bit_cast(unsigned, r);
}
__device__ __forceinline__ u16 f2bf(float a) { return (u16)(pk2(a, 0.f) & 0xffffu); }
__device__ __forceinline__ float lo16(unsigned x) { return __uint_as_float(x << 16); }
__device__ __forceinline__ float hi16(unsigned x) { return __uint_as_float(x & 0xffff0000u); }
__device__ __forceinline__ void store8(u16* dst, const float* v) {
  u4 o;
  o[0] = pk2(v[0], v[1]); o[1] = pk2(v[2], v[3]); o[2] = pk2(v[4], v[5]); o[3] = pk2(v[6], v[7]);
  *(u4*)dst = o;
}
__device__ __forceinline__ float wsum(float x) {
  x += __builtin_bit_cast(float, __builtin_amdgcn_update_dpp(0, __builtin_bit_cast(int, x), 0xB1, 0xF, 0xF, true));
  x += __builtin_bit_cast(float, __builtin_amdgcn_update_dpp(0, __builtin_bit_cast(int, x), 0x4E, 0xF, 0xF, true));
  x += __builtin_bit_cast(float, __builtin_amdgcn_update_dpp(0, __builtin_bit_cast(int, x), 0x141, 0xF, 0xF, true));
  x += __builtin_bit_cast(float, __builtin_amdgcn_update_dpp(0, __builtin_bit_cast(int, x), 0x140, 0xF, 0xF, true));
  x += __builtin_bit_cast(float, __builtin_amdgcn_update_dpp(0, __builtin_bit_cast(int, x), 0x142, 0xA, 0xF, false));
  x += __builtin_bit_cast(float, __builtin_amdgcn_update_dpp(0, __builtin_bit_cast(int, x), 0x143, 0xC, 0xF, false));
  return __builtin_bit_cast(float, __builtin_amdgcn_readlane(__builtin_bit_cast(int, x), 63));
}
__device__ __forceinline__ float xhalf_max(float v) {
  auto r = __builtin_amdgcn_permlane32_swap(__float_as_uint(v), __float_as_uint(v), false, false);
  return fmaxf(__uint_as_float(r[0]), __uint_as_float(r[1]));
}
__device__ __forceinline__ float xhalf_sum(float v) {
  auto r = __builtin_amdgcn_permlane32_swap(__float_as_uint(v), __float_as_uint(v), false, false);
  return __uint_as_float(r[0]) + __uint_as_float(r[1]);
}
__device__ __forceinline__ int ltid() { int t = threadIdx.x; asm volatile("" : "+v"(t)); return t; }
__device__ __forceinline__ float fexp2(float x) { return __builtin_amdgcn_exp2f(x); }
__device__ __forceinline__ float fsigmoid(float x) { return __builtin_amdgcn_rcpf(1.f + fexp2(-x * LOG2E)); }
__device__ __forceinline__ int swz23(int r) { return (r & 0x13) | ((r & 4) << 1) | ((r & 8) >> 1); }

__device__ __forceinline__ float* xrow(const Params& p, int row) {
  int b = row >= TT ? 1 : 0;
  int t = row - b * TT;
  if (t < CTX) return (float*)(p.ws + OFF_CTXRES) + (size_t)(b * CTX + t) * DM;
  return p.out + (size_t)(b * SEQ + t - CTX) * DM;
}
__device__ __forceinline__ const float* modrow(const Params& p, int layer, int row) {
  int b = row >= TT ? 1 : 0;
  int t = row - b * TT;
  int which = t < CTX ? 2 : b;
  return (const float*)(p.ws + OFF_MOD) + (size_t)(layer * 3 + which) * 6 * DM;
}

__device__ __forceinline__ bool gemm_tile_of(int k, int ntn, int& mt, int& nt) {
  const int x = blockIdx.x & 7, lb = blockIdx.x >> 3, nlb = gridDim.x >> 3;
  const int mstart = x * 32 + (x < 4 ? x : 4), mcount = 32 + (x < 4 ? 1 : 0);
  const int j = lb + k * nlb;
  if (j >= mcount * ntn) return false;
  int mg, rm, jj;
  if (j < 32 * ntn) { mg = j / (8 * ntn); rm = 8; jj = j - mg * 8 * ntn; }
  else { mg = 4; rm = 1; jj = j - 32 * ntn; }
  nt = jj / rm;
  mt = mstart + mg * 8 + (jj - nt * rm);
  return true;
}

template <int NI>
struct GemmPipe { u4 ra0[4], rb0[2 * NI], ra1[4], rb1[2 * NI]; };

template <int NI>
__device__ __forceinline__ void gemm_prefetch(GemmPipe<NI>& pp, const u16* __restrict__ A, int lda,
                                              const u16* __restrict__ B, int ldb) {
  const int tid = ltid();
  const int crow = tid >> 3, ckc = (tid & 7) * 8;
  const u16* Ap = A + (size_t)crow * lda + ckc;
  const u16* Bp = B + (size_t)crow * ldb + ckc;
  const size_t astep = (size_t)32 * lda, bstep = (size_t)32 * ldb;
#pragma unroll
  for (int i = 0; i < 4; i++) { pp.ra0[i] = *(const u4*)(Ap + i * astep); pp.ra1[i] = *(const u4*)(Ap + i * astep + 64); }
#pragma unroll
  for (int i = 0; i < 2 * NI; i++) { pp.rb0[i] = *(const u4*)(Bp + i * bstep); pp.rb1[i] = *(const u4*)(Bp + i * bstep + 64); }
}

template <int NI>
__device__ __forceinline__ void gemm_main(f16 (&acc)[2][NI], GemmPipe<NI>& pp, const u16* __restrict__ A, int lda,
                                          const u16* __restrict__ B, int ldb, int K, u16* sm) {
  const int tid = ltid(), lane = tid & 63, wid = tid >> 6, wm = wid >> 1, wn = wid & 1;
  const int r = lane & 31, hh = lane >> 5;
  u16* sa = sm;
  u16* sb = sm + 2 * 128 * LDT;
  const int nk = K >> 6;
  const int crow = tid >> 3, ckc = (tid & 7) * 8;
  const u16* Ap = A + (size_t)crow * lda + ckc;
  const u16* Bp = B + (size_t)crow * ldb + ckc;
  const size_t astep = (size_t)32 * lda, bstep = (size_t)32 * ldb;
  auto gload = [&](u4 (&ra)[4], u4 (&rb)[2 * NI], int kt) {
#pragma unroll
    for (int i = 0; i < 4; i++) ra[i] = *(const u4*)(Ap + i * astep + kt * 64);
#pragma unroll
    for (int i = 0; i < 2 * NI; i++) rb[i] = *(const u4*)(Bp + i * bstep + kt * 64);
  };
  auto swrite = [&](const u4 (&ra)[4], const u4 (&rb)[2 * NI], int buf) {
    const int nb = buf * 128 * LDT;
#pragma unroll
    for (int i = 0; i < 4; i++) *(u4*)(sa + nb + (crow + 32 * i) * LDT + ckc) = ra[i];
#pragma unroll
    for (int i = 0; i < 2 * NI; i++) *(u4*)(sb + nb + (crow + 32 * i) * LDT + ckc) = rb[i];
  };
  auto compute = [&](int buf) {
    const u16* a0 = sa + buf * 128 * LDT + (64 * wm + r) * LDT + 8 * hh;
    const u16* b0 = sb + buf * 128 * LDT + (32 * NI * wn + r) * LDT + 8 * hh;
#pragma unroll
    for (int s = 0; s < 4; s++) {
      bf8 af[2], bfr[NI];
#pragma unroll
      for (int mi = 0; mi < 2; mi++) af[mi] = *(const bf8*)(a0 + mi * 32 * LDT + 16 * s);
#pragma unroll
      for (int ni = 0; ni < NI; ni++) bfr[ni] = *(const bf8*)(b0 + ni * 32 * LDT + 16 * s);
#pragma unroll
      for (int mi = 0; mi < 2; mi++)
#pragma unroll
        for (int ni = 0; ni < NI; ni++)
          acc[mi][ni] = __builtin_amdgcn_mfma_f32_32x32x16_bf16(af[mi], bfr[ni], acc[mi][ni], 0, 0, 0);
    }
  };
  swrite(pp.ra0, pp.rb0, 0);
  __syncthreads();
  for (int kt = 0; kt < nk; kt += 2) {
    if (kt + 2 < nk) gload(pp.ra0, pp.rb0, kt + 2);
    compute(0);
    swrite(pp.ra1, pp.rb1, 1);
    __syncthreads();
    if (kt + 3 < nk) gload(pp.ra1, pp.rb1, kt + 3);
    compute(1);
    if (kt + 2 < nk) swrite(pp.ra0, pp.rb0, 0);
    __syncthreads();
  }
}

template <int NI>
struct GemmPipe1 { u4 ra[4], rb[2 * NI]; };
template <int NI>
__device__ __forceinline__ void gemm_prefetch1(GemmPipe1<NI>& pp, const u16* __restrict__ A, int lda,
                                               const u16* __restrict__ B, int ldb) {
  const int tid = ltid();
  const int crow = tid >> 3, ckc = (tid & 7) * 8;
#pragma unroll
  for (int i = 0; i < 4; i++) pp.ra[i] = *(const u4*)(A + (size_t)(crow + 32 * i) * lda + ckc);
#pragma unroll
  for (int i = 0; i < 2 * NI; i++) pp.rb[i] = *(const u4*)(B + (size_t)(crow + 32 * i) * ldb + ckc);
}
template <int NI>
__device__ __forceinline__ void gemm_main1(f16 (&acc)[2][NI], GemmPipe1<NI>& pp, const u16* __restrict__ A, int lda,
                                           const u16* __restrict__ B, int ldb, int K, u16* sm) {
  const int tid = ltid(), lane = tid & 63, wid = tid >> 6, wm = wid >> 1, wn = wid & 1;
  const int r = lane & 31, hh = lane >> 5;
  u16* sa = sm;
  u16* sb = sm + 2 * 128 * LDT;
  const int nk = K >> 6;
  const int crow = tid >> 3, ckc = (tid & 7) * 8;
  const u16* Ap = A + (size_t)crow * lda + ckc;
  const u16* Bp = B + (size_t)crow * ldb + ckc;
  const size_t astep = (size_t)32 * lda, bstep = (size_t)32 * ldb;
  auto swrite = [&](int buf) {
    const int nb = buf * 128 * LDT;
#pragma unroll
    for (int i = 0; i < 4; i++) *(u4*)(sa + nb + (crow + 32 * i) * LDT + ckc) = pp.ra[i];
#pragma unroll
    for (int i = 0; i < 2 * NI; i++) *(u4*)(sb + nb + (crow + 32 * i) * LDT + ckc) = pp.rb[i];
  };
  swrite(0);
  __syncthreads();
  for (int kt = 0; kt < nk; kt++) {
    if (kt + 1 < nk) {
#pragma unroll
      for (int i = 0; i < 4; i++) pp.ra[i] = *(const u4*)(Ap + i * astep + (kt + 1) * 64);
#pragma unroll
      for (int i = 0; i < 2 * NI; i++) pp.rb[i] = *(const u4*)(Bp + i * bstep + (kt + 1) * 64);
    }
    const u16* a0 = sa + (kt & 1) * 128 * LDT + (64 * wm + r) * LDT + 8 * hh;
    const u16* b0 = sb + (kt & 1) * 128 * LDT + (32 * NI * wn + r) * LDT + 8 * hh;
#pragma unroll
    for (int s = 0; s < 4; s++) {
      bf8 af[2], bfr[NI];
#pragma unroll
      for (int mi = 0; mi < 2; mi++) af[mi] = *(const bf8*)(a0 + mi * 32 * LDT + 16 * s);
#pragma unroll
      for (int ni = 0; ni < NI; ni++) bfr[ni] = *(const bf8*)(b0 + ni * 32 * LDT + 16 * s);
#pragma unroll
      for (int mi = 0; mi < 2; mi++)
#pragma unroll
        for (int ni = 0; ni < NI; ni++)
          acc[mi][ni] = __builtin_amdgcn_mfma_f32_32x32x16_bf16(af[mi], bfr[ni], acc[mi][ni], 0, 0, 0);
    }
    if (kt + 1 < nk) swrite((kt + 1) & 1);
    __syncthreads();
  }
}

template <int NI, class F>
__device__ __forceinline__ void gemm_epi(f16 (&acc)[2][NI], float* ep, F&& f) {
  const int tid = ltid(), lane = tid & 63, wid = tid >> 6, wm = wid >> 1, wn = wid & 1;
  const int r = lane & 31, hh = lane >> 5;
#pragma unroll
  for (int mi = 0; mi < 2; mi++)
#pragma unroll
    for (int ni = 0; ni < NI; ni++)
#pragma unroll
      for (int i = 0; i < 16; i++) {
        int row = 64 * wm + 32 * mi + (i & 3) + 8 * (i >> 2) + 4 * hh;
        int col = 32 * NI * wn + 32 * ni + r;
        ep[row * EPS + col] = acc[mi][ni][i];
      }
  __syncthreads();
  constexpr int CG = 8 * NI;
  for (int u = tid; u < 128 * CG; u += 256) {
    int row = u / CG, c8 = (u % CG) * 8;
    f(row, c8, ep + row * EPS + c8);
  }
  __syncthreads();
}

template <int NI>
__device__ __forceinline__ void zero_acc(f16 (&acc)[2][NI]) {
#pragma unroll
  for (int mi = 0; mi < 2; mi++)
#pragma unroll
    for (int ni = 0; ni < NI; ni++)
#pragma unroll
      for (int i = 0; i < 16; i++) acc[mi][ni][i] = 0.f;
}

__device__ __forceinline__ void wconv_tile(const float* __restrict__ src, u16* __restrict__ dst, int K, int N, int idx, float* tl) {
  const int tid = ltid();
  const int ntn = N >> 6;
  const int kt = idx / ntn, nt = idx - kt * ntn;
  const int k0 = kt * 64, n0 = nt * 64;
  const int a = tid >> 6, bb = tid & 63;
  float wv[16];
#pragma unroll
  for (int i = 0; i < 16; i++) wv[i] = src[(size_t)(k0 + i * 4 + a) * N + n0 + bb];
#pragma unroll
  for (int i = 0; i < 16; i++) tl[(i * 4 + a) * 65 + bb] = wv[i];
  __syncthreads();
#pragma unroll 4
  for (int i = 0; i < 16; i++) {
    int n = i * 4 + a;
    dst[(size_t)(n0 + n) * K + k0 + bb] = f2bf(tl[bb * 65 + n]);
  }
  __syncthreads();
}

__device__ __forceinline__ void wconv_layer(const Params& p, int l, unsigned char* smem) {
  float* tl = (float*)smem;
  u16* winT = (u16*)(p.ws + OFF_WA);
  u16* wbrT = winT + (size_t)WINC * DM;
  u16* woutT = wbrT + (size_t)4 * DM * 256;
  u16* wupT = (u16*)(p.ws + OFF_WM);
  u16* wdnT = wupT + (size_t)DFF * DM;
  const int n0 = 1824, n1 = n0 + 256, n2 = n1 + 256, n3 = n2 + 1024, n4 = n3 + 1024;
  for (int it = blockIdx.x; it < n4; it += gridDim.x) {
    if (it < n0) wconv_tile(p.w_in + (size_t)l * DM * WINC, winT, DM, WINC, it, tl);
    else if (it < n1) {
      int j = it - n0, n = j >> 6;
      wconv_tile(p.w_branch + ((size_t)l * 4 + n) * 256 * DM, wbrT + (size_t)n * DM * 256, 256, DM, j & 63, tl);
    } else if (it < n2) wconv_tile(p.w_out + (size_t)l * DM * DM, woutT, DM, DM, it - n1, tl);
    else if (it < n3) wconv_tile(p.w_up + (size_t)l * DM * DFF, wupT, DM, DFF, it - n2, tl);
    else wconv_tile(p.w_down + (size_t)l * DFF * DM, wdnT, DFF, DM, it - n3, tl);
  }
}

__device__ __forceinline__ void phase_pro(const Params& p, unsigned char* smem) {
  const int tid = ltid(), lane = tid & 63, wid = tid >> 6;
  float* sil = (float*)smem;
  float* red = sil + 3 * DM;
  float* modv = (float*)(p.ws + OFF_MOD);
  for (int it = blockIdx.x; it < DEPTH * 96; it += gridDim.x) {
    int l = it / 96, cgp = it - l * 96;
    for (int i = tid; i < 3 * DM; i += 256) {
      int w = i >> 10, k = i & 1023;
      float v = w < 2 ? p.c[w * DM + k] : p.c_ctx[k];
      sil[i] = v * fsigmoid(v);
    }
    __syncthreads();
    const float* W = p.ada_w + (size_t)l * DM * 6 * DM + cgp * 64 + lane;
    float a0 = 0.f, a1 = 0.f, a2 = 0.f;
#pragma unroll 16
    for (int k = wid * 256; k < wid * 256 + 256; k++) {
      float w = W[(size_t)k * 6 * DM];
      a0 += sil[k] * w; a1 += sil[DM + k] * w; a2 += sil[2 * DM + k] * w;
    }
    red[(wid * 3 + 0) * 64 + lane] = a0; red[(wid * 3 + 1) * 64 + lane] = a1; red[(wid * 3 + 2) * 64 + lane] = a2;
    __syncthreads();
    if (tid < 192) {
      int w = tid >> 6;
      float s = red[(0 * 3 + w) * 64 + lane] + red[(1 * 3 + w) * 64 + lane] + red[(2 * 3 + w) * 64 + lane] + red[(3 * 3 + w) * 64 + lane];
      int col = cgp * 64 + lane;
      modv[(size_t)(l * 3 + w) * 6 * DM + col] = s + p.ada_b[(size_t)l * 6 * DM + col];
    }
    __syncthreads();
  }
  const size_t gtid = (size_t)blockIdx.x * 256 + tid, gsz = (size_t)gridDim.x * 256;
  {
    const f4* src = (const f4*)p.x; f4* dst = (f4*)p.out;
    for (size_t i = gtid; i < (size_t)NB * SEQ * DM / 4; i += gsz) dst[i] = src[i];
    const f4* s2 = (const f4*)p.ctx; f4* d2 = (f4*)(p.ws + OFF_CTXRES);
    for (size_t i = gtid; i < (size_t)NB * CTX * DM / 4; i += gsz) d2[i] = s2[i];
  }
  {
    f2* tabC = (f2*)(p.ws + OFF_TAB);
    f2* tabAr = tabC + 16384 * 16; f2* tabAc = tabAr + 256 * 8; f2* tabDr = tabAc + 64 * 8; f2* tabDc = tabDr + 256 * 16;
    const int total = 16384 * 16 + 256 * 8 + 64 * 8 + 256 * 16 + 64 * 16;
    for (size_t i = gtid; i < (size_t)total; i += gsz) {
      int e = (int)i; int pos, j, nf; f2* dst;
      if (e < 16384 * 16) { pos = e >> 4; j = e & 15; nf = 16; dst = tabC + e; }
      else if ((e -= 16384 * 16) < 256 * 8) { pos = e >> 3; j = e & 7; nf = 8; dst = tabAr + e; }
      else if ((e -= 256 * 8) < 64 * 8) { pos = e >> 3; j = e & 7; nf = 8; dst = tabAc + e; }
      else if ((e -= 64 * 8) < 256 * 16) { pos = e >> 4; j = e & 15; nf = 16; dst = tabDr + e; }
      else { e -= 256 * 16; pos = e >> 4; j = e & 15; nf = 16; dst = tabDc + e; }
      double base = nf == 8 ? 0.31622776601683794 : 0.5623413251903491;
      double f = 1.0;
      for (int q = 0; q < j; q++) f *= base;
      float inv = (float)f;
      float ang = (float)pos * inv;
      double rev = (double)ang * 0.15915494309189535;
      rev -= floor(rev);
      float rv = (float)rev;
      f2 cs; cs.x = __builtin_amdgcn_cosf(rv); cs.y = __builtin_amdgcn_sinf(rv);
      *dst = cs;
    }
  }
  wconv_layer(p, 0, smem);
}

__device__ __forceinline__ void phase_rows(const Params& p, int l, int mode) {
  const int tid = ltid(), lane = tid & 63, wid = __builtin_amdgcn_readfirstlane(tid >> 6);
  u16* H = (u16*)(p.ws + OFF_H);
  const u16* src = (const u16*)(p.ws + (mode == 1 ? OFF_MO : OFF_DN));
  for (int row = blockIdx.x * 4 + wid; row < NR; row += gridDim.x * 4) {
    float* xr = xrow(p, row);
    f4 xv[4];
#pragma unroll
    for (int i = 0; i < 4; i++) xv[i] = *(const f4*)(xr + lane * 4 + 256 * i);
    if (mode != 0) {
      const float* md = modrow(p, l, row);
      const float* gt = md + (mode == 1 ? 2 : 5) * DM;
      const float* gpost = (mode == 1 ? p.n_post_mix : p.n_post_mlp) + (size_t)l * DM;
      float mv[4][4]; float ss = 0.f;
#pragma unroll
      for (int i = 0; i < 4; i++) {
        u2 raw = *(const u2*)(src + (size_t)row * DM + lane * 4 + 256 * i);
        mv[i][0] = lo16(raw[0]); mv[i][1] = hi16(raw[0]); mv[i][2] = lo16(raw[1]); mv[i][3] = hi16(raw[1]);
#pragma unroll
        for (int j = 0; j < 4; j++) ss += mv[i][j] * mv[i][j];
      }
      ss = wsum(ss);
      float rs = rsqrtf(ss * (1.f / DM) + 1e-6f);
#pragma unroll
      for (int i = 0; i < 4; i++) {
        f4 g4 = *(const f4*)(gpost + lane * 4 + 256 * i);
        f4 t4 = *(const f4*)(gt + lane * 4 + 256 * i);
#pragma unroll
        for (int j = 0; j < 4; j++) xv[i][j] += t4[j] * (mv[i][j] * rs * g4[j]);
        *(f4*)(xr + lane * 4 + 256 * i) = xv[i];
      }
    }
    int ln = mode == 2 ? l + 1 : l;
    if (ln < DEPTH) {
      const float* md = modrow(p, ln, row);
      const float* sh = md + (mode == 1 ? 3 : 0) * DM;
      const float* sc = md + (mode == 1 ? 4 : 1) * DM;
      const float* gpre = (mode == 1 ? p.n_pre_mlp : p.n_pre_mix) + (size_t)ln * DM;
      float ss = 0.f;
#pragma unroll
      for (int i = 0; i < 4; i++)
#pragma unroll
        for (int j = 0; j < 4; j++) ss += xv[i][j] * xv[i][j];
      ss = wsum(ss);
      float rs = rsqrtf(ss * (1.f / DM) + 1e-6f);
#pragma unroll
      for (int i = 0; i < 4; i++) {
        f4 g4 = *(const f4*)(gpre + lane * 4 + 256 * i);
        f4 s4 = *(const f4*)(sh + lane * 4 + 256 * i);
        f4 c4 = *(const f4*)(sc + lane * 4 + 256 * i);
        float o[4];
#pragma unroll
        for (int j = 0; j < 4; j++) o[j] = xv[i][j] * rs * g4[j] * (1.f + c4[j]) + s4[j];
        u2 pk; pk[0] = pk2(o[0], o[1]); pk[1] = pk2(o[2], o[3]);
        *(u2*)(H + (size_t)row * DM + lane * 4 + 256 * i) = pk;
      }
    }
  }
}

__device__ __forceinline__ void phase_gemm1(const Params& p, int l, unsigned char* smem) {
  const u16* H = (const u16*)(p.ws + OFF_H);
  const u16* winT = (const u16*)(p.ws + OFF_WA);
  u16* ACD = (u16*)(p.ws + OFF_ACD);
  u16* CB = (u16*)(p.ws + OFF_CB);
  const f2* tabC = (const f2*)(p.ws + OFF_TAB);
  const f2* tabAr = tabC + 16384 * 16; const f2* tabAc = tabAr + 256 * 8; const f2* tabDr = tabAc + 64 * 8; const f2* tabDc = tabDr + 256 * 16;
  GemmPipe<2> pp;
  int mt, nt;
  bool have = gemm_tile_of(0, 25, mt, nt);
  if (have) gemm_prefetch<2>(pp, H + (size_t)mt * 128 * DM, DM, winT + (size_t)nt * 128 * DM, DM);
  for (int kk = 0; have; kk++) {
    const int m0 = mt * 128, n0 = nt * 128;
    f16 acc[2][2];
    zero_acc<2>(acc);
    gemm_main<2>(acc, pp, H + (size_t)m0 * DM, DM, winT + (size_t)n0 * DM, DM, DM, (u16*)smem);
    const int ntc = nt;
    have = gemm_tile_of(kk + 1, 25, mt, nt);
    if (have) gemm_prefetch<2>(pp, H + (size_t)mt * 128 * DM, DM, winT + (size_t)nt * 128 * DM, DM);
    {
      const int nt = ntc;
    int cls; float scale = 1.f; u16* dst; int dpitch;
    if (nt < 4) { cls = 1; if (nt < 2) scale = 0.17677669529663687f * LOG2E; }
    else if (nt == 15 || nt == 16) { cls = 2; if (nt == 16) scale = 0.17677669529663687f; }
    else if (nt >= 21 && nt < 24) { cls = 3; if (nt < 23) scale = 0.125f * LOG2E; }
    else cls = 0;
    if (n0 < 768) { dst = ACD + n0; dpitch = PACD; }
    else if (n0 < 1920) { dst = CB + (n0 - 768); dpitch = PCB; }
    else { dst = ACD + (n0 - 1152); dpitch = PACD; }
    gemm_epi<2>(acc, (float*)smem, [&](int row, int c8, const float* e) {
      const int grow = m0 + row;
      const int b = grow >= TT ? 1 : 0;
      const int t = grow - b * TT;
      float v[8];
      if (cls == 0 || t < CTX) {
#pragma unroll
        for (int i = 0; i < 8; i++) v[i] = e[i] * scale;
      } else {
        const int n = t - CTX;
        const f2* tb; bool first; int dist;
        if (cls == 1) { int ee = c8 & 31; int half = ee >> 4; first = (ee & 15) < 8; dist = 8; tb = half ? tabAc + (n & 63) * 8 : tabAr + (n >> 6) * 8; }
        else if (cls == 2) { int ee = c8 & 31; first = ee < 16; dist = 16; tb = tabC + n * 16 + (ee & 15); }
        else { int ee = c8 & 63; int half = ee >> 5; int i0 = ee & 31; first = i0 < 16; dist = 16; tb = (half ? tabDc + (n & 63) * 16 : tabDr + (n >> 6) * 16) + (i0 & 15); }
#pragma unroll
        for (int i = 0; i < 8; i++) {
          f2 cs = tb[i];
          float pp = first ? -e[i + dist] : e[i - dist];
          v[i] = (e[i] * cs.x + pp * cs.y) * scale;
        }
      }
      store8(dst + (size_t)grow * dpitch + c8, v);
    });
    }
  }
}

__device__ __forceinline__ void prepb_tile(const Params& p, int l, int tile, float* act) {
  const int c = ltid(), lane = c & 63;
  const u16* CB = (const u16*)(p.ws + OFF_CB);
  u16* scan = (u16*)(p.ws + OFF_SCAN);
  u16* GB = (u16*)(p.ws + OFF_GB);
  const int r0 = tile * 16;
  const int b = r0 >= TT ? 1 : 0;
  const int t0 = r0 - b * TT;
  const int seg0 = t0 < CTX ? 0 : CTX, seg1 = t0 < CTX ? CTX : TT;
  const float* mu = p.mu + (size_t)l * PCB;
  const float mu0 = mu[c], mu1 = mu[256 + c], mu2 = mu[512 + c], mu3 = mu[768 + c], mu4 = c < 128 ? mu[1024 + c] : 0.f;
  const float ckk = p.rkk[l * 256 + c], cka = p.rka[l * 256 + c];
  float* kls = act + 16 * 384;
  float* kkls = kls + 16 * 256;
  u16 raw[18][5];
#pragma unroll
  for (int j = 0; j < 18; j++) {
    const int t = t0 - 1 + j;
    const bool ok = t >= seg0 && t < seg1;
    const u16* rp = CB + (size_t)(b * TT + (ok ? t : t0)) * PCB;
    raw[j][0] = rp[c]; raw[j][1] = rp[256 + c]; raw[j][2] = rp[512 + c]; raw[j][3] = rp[768 + c];
    raw[j][4] = rp[1024 + (c & 127)];
    if (!ok) { raw[j][0] = 0; raw[j][1] = 0; raw[j][2] = 0; raw[j][3] = 0; raw[j][4] = 0; }
  }
#pragma unroll
  for (int j = 0; j < 16; j++) {
    const int t = t0 + j;
    const size_t orow = (size_t)(b * TT + t) * 256;
    const float cu0 = bf2f(raw[j + 1][0]), cu1 = bf2f(raw[j + 1][1]), cu2 = bf2f(raw[j + 1][2]), cu3 = bf2f(raw[j + 1][3]), cu4 = bf2f(raw[j + 1][4]);
    const float sm0 = 0.5f * (bf2f(raw[j][0]) + bf2f(raw[j + 2][0])), sm1 = 0.5f * (bf2f(raw[j][1]) + bf2f(raw[j + 2][1]));
    const float sm2 = 0.5f * (bf2f(raw[j][2]) + bf2f(raw[j + 2][2])), sm3 = 0.5f * (bf2f(raw[j][3]) + bf2f(raw[j + 2][3]));
    const float sm4 = 0.5f * (bf2f(raw[j][4]) + bf2f(raw[j + 2][4]));
    float xr = cu0 + (sm0 - cu0) * mu0;
    float xk = cu1 + (sm1 - cu1) * mu1;
    float xv = cu2 + (sm2 - cu2) * mu2;
    float x3 = cu3 + (sm3 - cu3) * mu3;
    float x4 = cu4 + (sm4 - cu4) * mu4;
    scan[0 * ARR + orow + c] = f2bf(xr);
    scan[1 * ARR + orow + c] = f2bf(xv);
    kls[j * 256 + c] = xk;
    float kk = xk * ckk;
    float ssq = wsum(kk * kk);
    kk *= rsqrtf(fmaxf(ssq, 1e-12f));
    kkls[j * 256 + c] = kk;
    scan[2 * ARR + orow + c] = f2bf(kk);
    act[j * 384 + c] = c < 128 ? (1.f - 2.f * __builtin_amdgcn_rcpf(1.f + __expf(2.f * x3))) : x3;
    if (c < 128) act[j * 384 + 256 + c] = fsigmoid(x4);
  }
  __syncthreads();
  const size_t obase = (size_t)(b * TT + t0) * 256 + c;
  {
    auto wptr = [&](int idx) -> const float* {
      if (idx < 8) {
        const int d = idx >> 2, isa = (idx >> 1) & 1, hf = idx & 1;
        return (isa ? p.a2 : p.w2) + ((size_t)(l * 2 + d) * 64 + hf * 32) * 256 + c;
      }
      return p.g2 + ((size_t)l * 128 + (idx - 8) * 32) * 256 + c;
    };
    auto aoff = [&](int idx) -> int {
      if (idx < 8) { const int d = idx >> 2, isa = (idx >> 1) & 1, hf = idx & 1; return (isa ? 128 : 0) + d * 64 + hf * 32; }
      return 256 + (idx - 8) * 32;
    };
    float wA[32], wB[32], acc[16];
#pragma unroll
    for (int k = 0; k < 32; k++) wA[k] = wptr(0)[k * 256];
#pragma unroll
    for (int j = 0; j < 16; j++) acc[j] = 0.f;
#pragma unroll
    for (int idx = 0; idx < 12; idx++) {
      if (idx + 1 < 12) {
        const float* wp = wptr(idx + 1);
        if ((idx & 1) == 0) {
#pragma unroll
          for (int k = 0; k < 32; k++) wB[k] = wp[k * 256];
        } else {
#pragma unroll
          for (int k = 0; k < 32; k++) wA[k] = wp[k * 256];
        }
      }
      const int ao = aoff(idx);
#pragma unroll
      for (int k = 0; k < 32; k += 4) {
#pragma unroll
        for (int j = 0; j < 16; j++) {
          f4 a = *(const f4*)(act + j * 384 + ao + k);
          if ((idx & 1) == 0) acc[j] += a[0] * wA[k] + a[1] * wA[k + 1] + a[2] * wA[k + 2] + a[3] * wA[k + 3];
          else acc[j] += a[0] * wB[k] + a[1] * wB[k + 1] + a[2] * wB[k + 2] + a[3] * wB[k + 3];
        }
      }
      if (idx == 1 || idx == 5) {
        const int d = idx >> 2;
        const float w0c = p.w0[(l * 2 + d) * 256 + c];
#pragma unroll
        for (int j = 0; j < 16; j++) {
          float xx = -(w0c + acc[j]);
          float sp = fmaxf(xx, 0.f) + __logf(1.f + __expf(-fabsf(xx)));
          float wlog = -sp - 0.5f;
          float lam = __expf(wlog) * LOG2E;
          scan[(3 + 3 * d) * ARR + obase + (size_t)j * 256] = f2bf(lam);
          acc[j] = 0.f;
        }
      } else if (idx == 3 || idx == 7) {
        const int d = idx >> 2;
        const float a0c = p.a0[(l * 2 + d) * 256 + c];
#pragma unroll
        for (int j = 0; j < 16; j++) {
          float a = fsigmoid(a0c + acc[j]);
          float kd = kls[j * 256 + c] * (1.f + (a - 1.f) * cka);
          scan[(4 + 3 * d) * ARR + obase + (size_t)j * 256] = f2bf(kd);
          scan[(5 + 3 * d) * ARR + obase + (size_t)j * 256] = f2bf(kkls[j * 256 + c] * a);
          acc[j] = 0.f;
        }
      } else if (idx == 11) {
#pragma unroll
        for (int j = 0; j < 16; j++) GB[obase + (size_t)j * 256] = f2bf(acc[j]);
      }
    }
  }
  __syncthreads();
}

__device__ __forceinline__ float ret_lg(const Params& p, int l, int d, int h) {
  float x = p.ret_decay[(l * 2 + d) * 4 + h];
  return -__log2f(1.f + __expf(-x));
}
__device__ __forceinline__ void retc1_item(const Params& p, int l, int item, float* sm) {
  const int tid = ltid();
  const int h = item & 3, bb = item >> 2;
  const int b = bb / 130, blk = bb - b * 130;
  const u16* ACD = (const u16*)(p.ws + OFF_ACD);
  float* Ks = sm;
  float* Vs = sm + 128 * 32;
  float* dec = Vs + 128 * 64;
  const size_t row0 = (size_t)b * TT + blk * 128;
  const float lgf = ret_lg(p, l, 0, h), lgb = ret_lg(p, l, 1, h);
  {
    u4 kv[2], vv[4];
#pragma unroll
    for (int i = 0; i < 2; i++) { const int ch = tid + 256 * i; kv[i] = *(const u4*)(ACD + (row0 + (ch >> 2)) * PACD + 896 + h * 32 + (ch & 3) * 8); }
#pragma unroll
    for (int i = 0; i < 4; i++) { const int ch = tid + 256 * i; vv[i] = *(const u4*)(ACD + (row0 + (ch >> 3)) * PACD + 1024 + h * 64 + (ch & 7) * 8); }
#pragma unroll
    for (int i = 0; i < 2; i++) {
      const int ch = tid + 256 * i, j = ch >> 2, q8 = (ch & 3) * 8;
#pragma unroll
      for (int e = 0; e < 4; e++) { Ks[j * 32 + q8 + 2 * e] = lo16(kv[i][e]); Ks[j * 32 + q8 + 2 * e + 1] = hi16(kv[i][e]); }
    }
#pragma unroll
    for (int i = 0; i < 4; i++) {
      const int ch = tid + 256 * i, j = ch >> 3, q8 = (ch & 7) * 8;
#pragma unroll
      for (int e = 0; e < 4; e++) { Vs[j * 64 + q8 + 2 * e] = lo16(vv[i][e]); Vs[j * 64 + q8 + 2 * e + 1] = hi16(vv[i][e]); }
    }
  }
  if (tid < 128) { dec[tid] = fexp2((127 - tid) * lgf); dec[128 + tid] = fexp2(tid * lgb); }
  __syncthreads();
  const int dv = tid & 63, dkg = tid >> 6;
  float af[8], ab[8];
#pragma unroll
  for (int i = 0; i < 8; i++) { af[i] = 0.f; ab[i] = 0.f; }
  for (int j = 0; j < 128; j++) {
    float v = Vs[j * 64 + dv];
    float vf = v * dec[j], vb = v * dec[128 + j];
    f4 k0 = *(const f4*)(Ks + j * 32 + dkg * 8), k1 = *(const f4*)(Ks + j * 32 + dkg * 8 + 4);
#pragma unroll
    for (int i = 0; i < 4; i++) { af[i] += k0[i] * vf; ab[i] += k0[i] * vb; af[4 + i] += k1[i] * vf; ab[4 + i] += k1[i] * vb; }
  }
  float* dS = (float*)(p.ws + OFF_DS);
  float* of = dS + ((size_t)(((b * 4 + h) * 2 + 0) * 130 + blk)) * 2048 + dv * 32 + dkg * 8;
  float* ob = dS + ((size_t)(((b * 4 + h) * 2 + 1) * 130 + blk)) * 2048 + dv * 32 + dkg * 8;
#pragma unroll
  for (int i = 0; i < 8; i++) { of[i] = af[i]; ob[i] = ab[i]; }
  __syncthreads();
}
__device__ __forceinline__ void retc2_item(const Params& p, int l, int item) {
  const int e = item * 256 + ltid();
  const int bhd = e >> 11, el = e & 2047;
  const int d = bhd & 1, h = (bhd >> 1) & 3;
  const float cdec = fexp2(128.f * ret_lg(p, l, d, h));
  const float* dS = (const float*)(p.ws + OFF_DS) + (size_t)bhd * 130 * 2048 + el;
  u16* Sin = (u16*)(p.ws + OFF_SIN) + (size_t)bhd * 130 * 2048 + el;
  float S = 0.f;
  for (int i0 = 0; i0 < 130; i0 += 13) {
    float dv[13];
#pragma unroll
    for (int u = 0; u < 13; u++) {
      const int i = i0 + u;
      const int blk = d == 0 ? i : (i == 0 ? 1 : (i == 1 ? 0 : 131 - i));
      dv[u] = dS[(size_t)blk * 2048];
    }
#pragma unroll
    for (int u = 0; u < 13; u++) {
      const int i = i0 + u;
      const int blk = d == 0 ? i : (i == 0 ? 1 : (i == 1 ? 0 : 131 - i));
      Sin[(size_t)blk * 2048] = f2bf(S);
      S = S * cdec + dv[u];
    }
  }
}
__device__ __forceinline__ void retc3_item(const Params& p, int l, int item, u16* sm) {
  const int tid = ltid(), lane = tid & 63, w = __builtin_amdgcn_readfirstlane(tid >> 6), r = lane & 31, hh = lane >> 5;
  const int h = item & 3, bb = item >> 2;
  const int b = bb / 130, blk = bb - b * 130;
  u16* ACD = (u16*)(p.ws + OFF_ACD);
  u16* Kt = sm;
  u16* Vt = sm + 128 * 40;
  const size_t row0 = (size_t)b * TT + blk * 128;
  const float lgf = ret_lg(p, l, 0, h), lgb = ret_lg(p, l, 1, h);
  const int iq = 32 * w + r;
  const size_t qrow = row0 + iq;
  u4 kst[2], vst[2][2], qraw[2], sfr[2][2][2];
  u2 graw[2][4];
#pragma unroll
  for (int i = 0; i < 2; i++) { const int cI = tid + 256 * i; kst[i] = *(const u4*)(ACD + (row0 + (cI >> 2)) * PACD + 896 + h * 32 + (cI & 3) * 8); }
#pragma unroll
  for (int i = 0; i < 2; i++) {
    const int u = tid + 256 * i, kp = u >> 3, dg = u & 7;
    vst[i][0] = *(const u4*)(ACD + (row0 + 2 * kp) * PACD + 1024 + h * 64 + dg * 8);
    vst[i][1] = *(const u4*)(ACD + (row0 + 2 * kp + 1) * PACD + 1024 + h * 64 + dg * 8);
  }
  qraw[0] = *(const u4*)(ACD + qrow * PACD + 768 + h * 32 + 8 * hh);
  qraw[1] = *(const u4*)(ACD + qrow * PACD + 768 + h * 32 + 16 + 8 * hh);
  {
    const u16* Sin = (const u16*)(p.ws + OFF_SIN);
#pragma unroll
    for (int d = 0; d < 2; d++)
#pragma unroll
      for (int s2 = 0; s2 < 2; s2++)
#pragma unroll
        for (int dt = 0; dt < 2; dt++)
          sfr[d][s2][dt] = *(const u4*)(Sin + ((size_t)(((b * 4 + h) * 2 + d) * 130 + blk)) * 2048 + (32 * dt + r) * 32 + 16 * s2 + 8 * hh);
  }
#pragma unroll
  for (int dt = 0; dt < 2; dt++)
#pragma unroll
    for (int i4 = 0; i4 < 4; i4++) graw[dt][i4] = *(const u2*)(ACD + qrow * PACD + 1280 + h * 64 + 32 * dt + 8 * i4 + 4 * hh);
#pragma unroll
  for (int i = 0; i < 2; i++) { const int cI = tid + 256 * i; *(u4*)(Kt + (cI >> 2) * 40 + (cI & 3) * 8) = kst[i]; }
#pragma unroll
  for (int i = 0; i < 2; i++) {
    const int u = tid + 256 * i, kp = u >> 3, dg = u & 7;
#pragma unroll
    for (int e = 0; e < 4; e++) {
      unsigned a = vst[i][0][e], c2 = vst[i][1][e];
      *(unsigned*)(Vt + (dg * 8 + 2 * e) * 136 + 2 * kp) = (a & 0xffffu) | (c2 << 16);
      *(unsigned*)(Vt + (dg * 8 + 2 * e + 1) * 136 + 2 * kp) = (a >> 16) | (c2 & 0xffff0000u);
    }
  }
  __syncthreads();
  f16 oacc[2];
#pragma unroll
  for (int i = 0; i < 16; i++) { oacc[0][i] = 0.f; oacc[1][i] = 0.f; }
#pragma unroll
  for (int kb = 0; kb < 4; kb++) {
    f16 st;
#pragma unroll
    for (int i = 0; i < 16; i++) st[i] = 0.f;
#pragma unroll
    for (int s = 0; s < 2; s++) {
      bf8 a = *(const bf8*)(Kt + (32 * kb + swz23(r)) * 40 + 16 * s + 8 * hh);
      st = __builtin_amdgcn_mfma_f32_32x32x16_bf16(a, __builtin_bit_cast(bf8, qraw[s]), st, 0, 0, 0);
    }
    u4 pb[2];
#pragma unroll
    for (int i = 0; i < 16; i++) {
      int key = 32 * kb + (i & 7) + 8 * hh + 16 * (i >> 3);
      int dd = iq - key;
      float wgt = dd > 0 ? fexp2((float)dd * lgf) : (dd < 0 ? fexp2((float)(-dd) * lgb) : 2.f);
      st[i] *= wgt;
    }
#pragma unroll
    for (int s = 0; s < 2; s++)
#pragma unroll
      for (int q = 0; q < 4; q++) pb[s][q] = pk2(st[8 * s + 2 * q], st[8 * s + 2 * q + 1]);
#pragma unroll
    for (int dt = 0; dt < 2; dt++)
#pragma unroll
      for (int s = 0; s < 2; s++) {
        bf8 a = *(const bf8*)(Vt + (32 * dt + r) * 136 + 32 * kb + 16 * s + 8 * hh);
        oacc[dt] = __builtin_amdgcn_mfma_f32_32x32x16_bf16(a, __builtin_bit_cast(bf8, pb[s]), oacc[dt], 0, 0, 0);
      }
  }
  {
    const float qdf = fexp2((float)(iq + 1) * lgf), qdb = fexp2((float)(128 - iq) * lgb);
#pragma unroll
    for (int d = 0; d < 2; d++) {
      const float qd = d == 0 ? qdf : qdb;
#pragma unroll
      for (int s = 0; s < 2; s++) {
        u4 qs;
#pragma unroll
        for (int q = 0; q < 4; q++) qs[q] = pk2(lo16(qraw[s][q]) * qd, hi16(qraw[s][q]) * qd);
#pragma unroll
        for (int dt = 0; dt < 2; dt++) {
          oacc[dt] = __builtin_amdgcn_mfma_f32_32x32x16_bf16(__builtin_bit_cast(bf8, sfr[d][s][dt]), __builtin_bit_cast(bf8, qs), oacc[dt], 0, 0, 0);
        }
      }
    }
  }
  float sum = 0.f;
#pragma unroll
  for (int dt = 0; dt < 2; dt++)
#pragma unroll
    for (int i = 0; i < 16; i++) sum += oacc[dt][i];
  sum = xhalf_sum(sum);
  const float mean = sum * (1.f / 64.f);
  float var = 0.f;
#pragma unroll
  for (int dt = 0; dt < 2; dt++)
#pragma unroll
    for (int i = 0; i < 16; i++) { float dlt = oacc[dt][i] - mean; var += dlt * dlt; }
  var = xhalf_sum(var) * (1.f / 64.f);
  const float rstd = rsqrtf(var + 1e-5f);
  const float* gn = p.ret_gn + l * 256 + h * 64;
#pragma unroll
  for (int dt = 0; dt < 2; dt++)
#pragma unroll
    for (int i4 = 0; i4 < 4; i4++) {
      const int dv = 32 * dt + 8 * i4 + 4 * hh;
      u16* gp = ACD + qrow * PACD + 1280 + h * 64 + dv;
      const u2 gr = graw[dt][i4];
      float g[4] = {lo16(gr[0]), hi16(gr[0]), lo16(gr[1]), hi16(gr[1])};
      float o[4];
#pragma unroll
      for (int q = 0; q < 4; q++) {
        float y = (oacc[dt][4 * i4 + q] - mean) * rstd * gn[dv + q];
        o[q] = y * g[q] * fsigmoid(g[q]);
      }
      u2 ov; ov[0] = pk2(o[0], o[1]); ov[1] = pk2(o[2], o[3]);
      *(u2*)gp = ov;
    }
  __syncthreads();
}

constexpr int SLOT = 64 * LDT;
constexpr int MABS = 68;
__device__ __forceinline__ int rw_row(int d, int b, int i) {
  int t = d == 0 ? i : (i < CTX ? CTX - 1 - i : TT + CTX - 1 - i);
  return b * TT + t;
}
template <bool PERM>
__device__ __forceinline__ void mm64(f16& acc, const u16* A, const u16* B, int tm, int tn, int r, int hh) {
  const int ar = PERM ? swz23(r) : r;
#pragma unroll
  for (int s = 0; s < 4; s++) {
    bf8 a = *(const bf8*)(A + (32 * tm + ar) * LDT + 16 * s + 8 * hh);
    bf8 bb = *(const bf8*)(B + (32 * tn + r) * LDT + 16 * s + 8 * hh);
    acc = __builtin_amdgcn_mfma_f32_32x32x16_bf16(a, bb, acc, 0, 0, 0);
  }
}
__device__ __forceinline__ void zero16(f16& a) {
#pragma unroll
  for (int i = 0; i < 16; i++) a[i] = 0.f;
}
template <int MASK>
__device__ __forceinline__ void put_tile(u16* dst, const f16& acc, int tm, int tn, int r, int hh) {
#pragma unroll
  for (int i = 0; i < 16; i++) {
    int row = 32 * tm + (i & 3) + 8 * (i >> 2) + 4 * hh, col = 32 * tn + r;
    float v = acc[i];
    if (MASK == 1 && !(row > col)) v = 0.f;
    if (MASK == 2 && !(row >= col)) v = 0.f;
    dst[row * LDT + col] = f2bf(v);
  }
}
template <int MASK>
__device__ __forceinline__ void put_tile_T(u16* dst, const f16& acc, int tm, int tn, int r, int hh) {
#pragma unroll
  for (int i4 = 0; i4 < 4; i4++) {
    const int row0 = 32 * tm + 8 * i4 + 4 * hh, col = 32 * tn + r;
    float v[4];
#pragma unroll
    for (int q = 0; q < 4; q++) {
      v[q] = acc[4 * i4 + q];
      if (MASK == 3 && !(((row0 + q) >> 4) > (col >> 4))) v[q] = 0.f;
    }
    u2 o; o[0] = pk2(v[0], v[1]); o[1] = pk2(v[2], v[3]);
    *(u2*)(dst + col * LDT + row0) = o;
  }
}

template <int MODE>
__device__ __forceinline__ void rwkv_chunk(const Params& p, int b, int h, int d, int c, u16* sm, f16& yout) {
  const int tid = ltid(), lane = tid & 63, w = __builtin_amdgcn_readfirstlane(tid >> 6), r = lane & 31, hh = lane >> 5;
  const int tm = w >> 1, tn = w & 1;
  u16 *x0 = sm, *x1 = sm + SLOT, *x2 = sm + 2 * SLOT, *x3 = sm + 3 * SLOT, *x4 = sm + 4 * SLOT, *x5 = sm + 5 * SLOT,
      *x6 = sm + 6 * SLOT, *x7 = sm + 7 * SLOT;
  float* dg = (float*)(sm + 8 * SLOT);
  float* qs = dg + 1024;
  float* wc = qs + 256;
  u16* AHT = MODE == 0 ? x6 : x5;
  u16* LTN = MODE == 0 ? x7 : x6;
  u16* TD = MODE == 0 ? x2 : x1;
  const u16* scan = (const u16*)(p.ws + OFF_SCAN);
  unsigned char* cbase = p.ws + OFF_CB + ((size_t)(((b * 4 + h) * 2 + d) * 260 + c)) * 16384;
  {
    const int k = lane, q = w, col = h * 64 + k;
    float lam[16], run = 0.f;
#pragma unroll
    for (int u = 0; u < 16; u++) {
      size_t ro = (size_t)rw_row(d, b, 64 * c + 16 * q + u) * 256 + col;
      lam[u] = bf2f(scan[(size_t)(3 + 3 * d) * ARR + ro]);
      run += lam[u];
    }
    u16 rkk[16], rbb[16], rkd[16], rvv[16], rrr[16];
#pragma unroll
    for (int u = 0; u < 16; u++) {
      size_t ro = (size_t)rw_row(d, b, 64 * c + 16 * q + u) * 256 + col;
      rkk[u] = scan[2 * ARR + ro];
      rbb[u] = scan[(size_t)(5 + 3 * d) * ARR + ro];
      rkd[u] = scan[(size_t)(4 + 3 * d) * ARR + ro];
      rvv[u] = scan[1 * ARR + ro];
      rrr[u] = MODE == 1 ? scan[0 * ARR + ro] : (u16)0;
    }
    qs[q * 64 + k] = run;
    __syncthreads();
    float pre = 0.f, tot = 0.f;
#pragma unroll
    for (int qq = 0; qq < 4; qq++) { float x = qs[qq * 64 + k]; tot += x; if (qq < q) pre += x; }
    float L = pre;
#pragma unroll
    for (int u = 0; u < 16; u++) {
      const int tau = 16 * q + u;
      const float Lp = L;
      L += lam[u];
      const float kk = bf2f(rkk[u]), bb = bf2f(rbb[u]);
      const float kd = bf2f(rkd[u]);
      const u16 vraw = rvv[u];
      const float eL = fexp2(L);
      const u16 ah = f2bf(kk * fexp2(-Lp));
      x0[tau * LDT + k] = ah;
      AHT[k * LDT + tau] = ah;
      x1[tau * LDT + k] = f2bf(bb * eL);
      x2[tau * LDT + k] = f2bf(kd * eL);
      x3[k * LDT + tau] = vraw;
      if (MODE == 0) {
        const float eC = fexp2(L - tot);
        x4[k * LDT + tau] = f2bf(bb * eC);
        x5[k * LDT + tau] = f2bf(kd * eC);
      } else {
        const float rr = bf2f(rrr[u]);
        x4[tau * LDT + k] = f2bf(rr * fexp2(-L));
      }
    }
    if (MODE == 0 && q == 0) wc[k] = fexp2(-tot);
    __syncthreads();
  }
  {
    f16 a_ab, a_ak, a_rb, a_rk;
    zero16(a_ab); zero16(a_ak); zero16(a_rb); zero16(a_rk);
    mm64<false>(a_ab, x0, x1, tm, tn, r, hh);
    mm64<false>(a_ak, x0, x2, tm, tn, r, hh);
    if (MODE == 1) {
      mm64<false>(a_rb, x4, x1, tm, tn, r, hh);
      mm64<false>(a_rk, x4, x2, tm, tn, r, hh);
    }
    __syncthreads();
#pragma unroll
    for (int i = 0; i < 16; i++) {
      int row = 32 * tm + (i & 3) + 8 * (i >> 2) + 4 * hh, col = 32 * tn + r;
      if ((row >> 4) == (col >> 4)) dg[(row >> 4) * 256 + (row & 15) * 16 + (col & 15)] = row > col ? a_ab[i] : 0.f;
    }
    put_tile_T<3>(LTN, a_ab, tm, tn, r, hh);
    put_tile<1>(x1, a_ak, tm, tn, r, hh);
    if (MODE == 1) { put_tile<2>(x2, a_rb, tm, tn, r, hh); put_tile<2>(x7, a_rk, tm, tn, r, hh); }
    __syncthreads();
  }
  {
    f16 a;
    zero16(a);
    mm64<false>(a, x1, x3, tm, tn, r, hh);
    float X[16];
    const int cc = lane & 15, gq = lane >> 4;
#pragma unroll
    for (int t = 0; t < 16; t++) {
      float acc = t == cc ? 1.f : 0.f;
#pragma unroll
      for (int j = 0; j < t; j++) acc -= dg[w * 256 + t * 16 + j] * X[j];
      X[t] = acc;
    }
    __syncthreads();
    put_tile_T<0>(x0, a, tm, tn, r, hh);
#pragma unroll
    for (int t = 0; t < 16; t++) TD[(16 * w + t) * LDT + 16 * gq + cc] = f2bf(gq == w ? X[t] : 0.f);
    __syncthreads();
  }
  {
    f16 n;
    zero16(n);
    mm64<false>(n, TD, LTN, tm, tn, r, hh);
    __syncthreads();
    put_tile<0>(LTN, n, tm, tn, r, hh);
    __syncthreads();
  }
  {
    f16 z0p, z0q;
    zero16(z0p); zero16(z0q);
    mm64<false>(z0p, TD, AHT, tm, tn, r, hh);
    mm64<false>(z0q, TD, x0, tm, tn, r, hh);
    __syncthreads();
    put_tile_T<0>(AHT, z0p, tm, tn, r, hh);
    put_tile_T<0>(x0, z0q, tm, tn, r, hh);
    __syncthreads();
#pragma unroll 1
    for (int itn = 0; itn < 3; itn++) {
      f16 np_, nq_;
      zero16(np_); zero16(nq_);
      mm64<false>(np_, LTN, AHT, tm, tn, r, hh);
      mm64<false>(nq_, LTN, x0, tm, tn, r, hh);
#pragma unroll
      for (int i = 0; i < 16; i++) { np_[i] = z0p[i] - np_[i]; nq_[i] = z0q[i] - nq_[i]; }
      __syncthreads();
      put_tile_T<0>(AHT, np_, tm, tn, r, hh);
      put_tile_T<0>(x0, nq_, tm, tn, r, hh);
      __syncthreads();
    }
  }
  if (MODE == 0) {
    f16 g;
    zero16(g);
    mm64<false>(g, x4, AHT, tm, tn, r, hh);
    u16* GT = (u16*)cbase;
#pragma unroll
    for (int i = 0; i < 16; i++) {
      int row = 32 * tm + (i & 3) + 8 * (i >> 2) + 4 * hh, col = 32 * tn + r;
      float v = (row == col ? wc[row] : 0.f) - g[i];
      GT[row * 64 + col] = f2bf(v);
    }
    f16 h1, h2;
    zero16(h1); zero16(h2);
    mm64<true>(h1, x5, x3, tm, tn, r, hh);
    mm64<true>(h2, x4, x0, tm, tn, r, hh);
    unsigned* HM = (unsigned*)(cbase + 8192) + (tm * 2 + tn) * 512;
#pragma unroll
    for (int q = 0; q < 8; q++) HM[q * 64 + lane] = pk2(h1[2 * q] - h2[2 * q], h1[2 * q + 1] - h2[2 * q + 1]);
    __syncthreads();
  } else {
    f16 ry, y1, y2;
    zero16(ry); zero16(y1); zero16(y2);
    mm64<false>(ry, x2, AHT, tm, tn, r, hh);
    mm64<false>(y1, x7, x3, tm, tn, r, hh);
    mm64<false>(y2, x2, x0, tm, tn, r, hh);
#pragma unroll
    for (int i = 0; i < 16; i++) {
      int row = 32 * tm + (i & 3) + 8 * (i >> 2) + 4 * hh, col = 32 * tn + r;
      x4[row * LDT + col] = f2bf(bf2f(x4[row * LDT + col]) - ry[i]);
      y1[i] -= y2[i];
    }
    __syncthreads();
    const unsigned char* S0 = cbase + 8192;
#pragma unroll
    for (int s = 0; s < 4; s++) {
      bf8 a = *(const bf8*)(x4 + (32 * tm + r) * LDT + 16 * s + 8 * hh);
      u4 bq = *(const u4*)(S0 + ((s >> 1) * 2 + tn) * 2048 + (s & 1) * 1024 + lane * 16);
      y1 = __builtin_amdgcn_mfma_f32_32x32x16_bf16(a, __builtin_bit_cast(bf8, bq), y1, 0, 0, 0);
    }
    yout = y1;
    __syncthreads();
  }
}

__device__ __forceinline__ void rwkv_s1_item(const Params& p, int item, u16* sm) {
  const int c = item % 260, chain = item / 260;
  f16 dummy;
  rwkv_chunk<0>(p, chain >> 3, (chain >> 1) & 3, chain & 1, c, sm, dummy);
}

__device__ __forceinline__ void rwkv_s2_item(const Params& p, int item) {
  const int tid = ltid(), lane = tid & 63, w = __builtin_amdgcn_readfirstlane(tid >> 6), r = lane & 31, hh = lane >> 5;
  const int chain = item * 2 + (w >> 1), vt = w & 1;
  unsigned char* base = p.ws + OFF_CB + (size_t)chain * 260 * 16384;
  f16 acc[2];
  zero16(acc[0]); zero16(acc[1]);
  u4 g[2][4]; unsigned hm[2][8];
  const int goff = (swz23(r) * 64 + 8 * hh) * 2;
#pragma unroll
  for (int kt = 0; kt < 2; kt++) {
#pragma unroll
    for (int s = 0; s < 4; s++) g[kt][s] = *(const u4*)(base + goff + kt * 32 * 128 + s * 32);
#pragma unroll
    for (int q = 0; q < 8; q++) hm[kt][q] = *(const unsigned*)(base + 8192 + (((kt * 2 + vt) * 8 + q) * 64 + lane) * 4);
  }
  for (int c = 0; c < 260; c++) {
    u4 gn[2][4]; unsigned hn[2][8];
    unsigned char* cb = base + (size_t)c * 16384;
    {
      const unsigned char* nb = base + (size_t)(c + 1 < 260 ? c + 1 : c) * 16384;
#pragma unroll
      for (int kt = 0; kt < 2; kt++) {
#pragma unroll
        for (int s = 0; s < 4; s++) gn[kt][s] = *(const u4*)(nb + goff + kt * 32 * 128 + s * 32);
#pragma unroll
        for (int q = 0; q < 8; q++) hn[kt][q] = *(const unsigned*)(nb + 8192 + (((kt * 2 + vt) * 8 + q) * 64 + lane) * 4);
      }
    }
    u4 bfg[4];
#pragma unroll
    for (int kt = 0; kt < 2; kt++)
#pragma unroll
      for (int s2 = 0; s2 < 2; s2++)
#pragma unroll
        for (int q = 0; q < 4; q++) bfg[2 * kt + s2][q] = pk2(acc[kt][8 * s2 + 2 * q], acc[kt][8 * s2 + 2 * q + 1]);
#pragma unroll
    for (int s = 0; s < 4; s++) *(u4*)(cb + 8192 + ((s >> 1) * 2 + vt) * 2048 + (s & 1) * 1024 + lane * 16) = bfg[s];
#pragma unroll
    for (int kt = 0; kt < 2; kt++) {
      f16 a;
#pragma unroll
      for (int q = 0; q < 8; q++) { a[2 * q] = lo16(hm[kt][q]); a[2 * q + 1] = hi16(hm[kt][q]); }
#pragma unroll
      for (int s = 0; s < 4; s++)
        a = __builtin_amdgcn_mfma_f32_32x32x16_bf16(__builtin_bit_cast(bf8, g[kt][s]), __builtin_bit_cast(bf8, bfg[s]), a, 0, 0, 0);
      acc[kt] = a;
    }
#pragma unroll
    for (int kt = 0; kt < 2; kt++) {
#pragma unroll
      for (int s = 0; s < 4; s++) g[kt][s] = gn[kt][s];
#pragma unroll
      for (int q = 0; q < 8; q++) hm[kt][q] = hn[kt][q];
    }
  }
}

__device__ __forceinline__ float qsum(float x) {
  x += __builtin_bit_cast(float, __builtin_amdgcn_update_dpp(0, __builtin_bit_cast(int, x), 0xB1, 0xF, 0xF, true));
  x += __builtin_bit_cast(float, __builtin_amdgcn_update_dpp(0, __builtin_bit_cast(int, x), 0x4E, 0xF, 0xF, true));
  return x;
}
__device__ __forceinline__ void rwkv_s3_item(const Params& p, int l, int item, u16* sm) {
  const int tid = ltid(), lane = tid & 63, w = __builtin_amdgcn_readfirstlane(tid >> 6), r = lane & 31, hh = lane >> 5;
  const int tm = w >> 1, tn = w & 1;
  const int tc = item % 260, bh = item / 260, b = bh >> 2, h = bh & 3;
  f16 yf, yb;
  zero16(yf); zero16(yb);
  for (int d = 0; d < 2; d++) {
    const int c = d == 0 ? tc : (tc < 4 ? 3 - tc : 263 - tc);
    f16 y;
    rwkv_chunk<1>(p, b, h, d, c, sm, y);
    if (d == 0) yf = y; else yb = y;
  }
  float* Ys = (float*)sm;
#pragma unroll
  for (int i = 0; i < 16; i++) {
    int row = 32 * tm + (i & 3) + 8 * (i >> 2) + 4 * hh;
    Ys[row * MABS + 32 * tn + r] = yf[i];
  }
  __syncthreads();
#pragma unroll
  for (int i = 0; i < 16; i++) {
    int row = 63 - (32 * tm + (i & 3) + 8 * (i >> 2) + 4 * hh);
    Ys[row * MABS + 32 * tn + r] += yb[i];
  }
  __syncthreads();
  {
    const int tok = tid >> 2, q4 = tid & 3;
    const size_t ro = (size_t)(b * TT + 64 * tc + tok) * 256 + h * 64 + 16 * q4;
    const u16* scan = (const u16*)(p.ws + OFF_SCAN);
    u16* GB = (u16*)(p.ws + OFF_GB);
    float y[16], sum = 0.f, sq = 0.f;
#pragma unroll
    for (int i = 0; i < 4; i++) {
      f4 v4 = *(const f4*)(Ys + tok * MABS + 16 * q4 + 4 * i);
#pragma unroll
      for (int j = 0; j < 4; j++) { y[4 * i + j] = v4[j]; sum += v4[j]; sq += v4[j] * v4[j]; }
    }
    sum = qsum(sum); sq = qsum(sq);
    const float mean = sum * (1.f / 64.f);
    const float var = fmaxf(sq * (1.f / 64.f) - mean * mean, 0.f);
    const float rstd = rsqrtf(var + 64e-5f);
    float rr[16], kf[16], kb[16], vv[16], gg[16];
    auto ld16 = [&](const u16* src, float* dst) {
      u4 a = *(const u4*)src, c2 = *(const u4*)(src + 8);
#pragma unroll
      for (int e = 0; e < 4; e++) { dst[2 * e] = lo16(a[e]); dst[2 * e + 1] = hi16(a[e]); dst[8 + 2 * e] = lo16(c2[e]); dst[8 + 2 * e + 1] = hi16(c2[e]); }
    };
    ld16(scan + 0 * ARR + ro, rr); ld16(scan + 4 * ARR + ro, kf); ld16(scan + 7 * ARR + ro, kb);
    ld16(scan + 1 * ARR + ro, vv); ld16(GB + ro, gg);
    const float* rk = p.rrk + l * 256 + h * 64 + 16 * q4;
    const float* lg = p.lnx_g + l * 256 + h * 64 + 16 * q4;
    const float* lb = p.lnx_b + l * 256 + h * 64 + 16 * q4;
    float bonus = 0.f;
#pragma unroll
    for (int i = 0; i < 16; i++) bonus += rr[i] * (kf[i] + kb[i]) * rk[i];
    bonus = qsum(bonus);
    float o[16];
#pragma unroll
    for (int i = 0; i < 16; i++) o[i] = ((y[i] - mean) * rstd * lg[i] + lb[i] + bonus * vv[i]) * gg[i];
    store8(GB + ro, o);
    store8(GB + ro + 8, o + 8);
  }
  __syncthreads();
}

template <int MODE>
__device__ __forceinline__ void attn_item(const Params& p, int l, int item, u16* sm) {
  constexpr int NS = MODE == 0 ? 2 : 4;
  const int tid = ltid(), lane = tid & 63, w = __builtin_amdgcn_readfirstlane(tid >> 6), r = lane & 31, hh = lane >> 5;
  const int pl = w >> 1, rb = w & 1;
  u16* ACD = (u16*)(p.ws + OFF_ACD);
  int b, hd, qrow0, ntile, jlo = 0, qb = 0;
  bool latent;
  if (MODE == 0) {
    if (item < 2048) { b = item >> 10; hd = (item >> 8) & 3; qb = item & 255; qrow0 = b * TT + CTX + 64 * qb; ntile = 260; latent = true; }
    else { int j = item - 2048; b = j >> 4; hd = (j >> 2) & 3; qrow0 = b * TT + 64 * (j & 3); ntile = 4; latent = false; }
  } else {
    if (item < 1024) {
      b = item >> 9; hd = (item >> 8) & 1; qb = item & 255; qrow0 = b * TT + CTX + 64 * qb; latent = true;
      jlo = qb - 2; if (jlo < 0) jlo = 0;
      int jhi = qb + 3; if (jhi > 256) jhi = 256;
      ntile = 4 + (jhi - jlo);
    } else { int j = item - 1024; b = j >> 3; hd = (j >> 2) & 1; qrow0 = b * TT + 64 * (j & 3); ntile = 4; latent = false; }
  }
  const int kcol = MODE == 0 ? 256 + hd * 64 : 1792 + hd * 64;
  const int vcol = MODE == 0 ? 512 + hd * 64 : 1920 + hd * 64;
  const int qcol = MODE == 0 ? hd * 64 + 32 * pl : 1536 + hd * 128 + 64 * pl;
  const int koff = MODE == 0 ? 32 * pl : 0;
  const size_t qrow = (size_t)qrow0 + 32 * rb + r;
  bf8 qf[NS];
#pragma unroll
  for (int s = 0; s < NS; s++) qf[s] = *(const bf8*)(ACD + qrow * PACD + qcol + 16 * s + 8 * hh);
  f16 O[2], negm, lacc;
  float m = 0.f;
#pragma unroll
  for (int i = 0; i < 16; i++) { O[0][i] = 0.f; O[1][i] = 0.f; negm[i] = 0.f; lacc[i] = 0.f; }
  u4 ones_u; ones_u[0] = ones_u[1] = ones_u[2] = ones_u[3] = 0x3F803F80u;
  const bf8 ones = __builtin_bit_cast(bf8, ones_u);
  auto keyrow0 = [&](int kt) -> size_t {
    if (MODE == 0 || kt < 4) return (size_t)b * TT + 64 * kt;
    return (size_t)b * TT + CTX + 64 * (jlo + kt - 4);
  };
  u4 rkA[2], rvA[2], rkB[2], rvB[2];
  const int kr = tid >> 3, kc = (tid & 7) * 8;
  const int kp = tid >> 3, dg = tid & 7;
  auto gload = [&](u4 (&rk)[2], u4 (&rv)[2], int kt) {
    const size_t k0 = keyrow0(kt);
    rk[0] = *(const u4*)(ACD + (k0 + kr) * PACD + kcol + kc);
    rk[1] = *(const u4*)(ACD + (k0 + kr + 32) * PACD + kcol + kc);
    rv[0] = *(const u4*)(ACD + (k0 + 2 * kp) * PACD + vcol + dg * 8);
    rv[1] = *(const u4*)(ACD + (k0 + 2 * kp + 1) * PACD + vcol + dg * 8);
  };
  auto swrite = [&](const u4 (&rk)[2], const u4 (&rv)[2], int buf) {
    u16* Kb = sm + buf * 2 * 64 * LDT;
    u16* Vb = Kb + 64 * LDT;
    *(u4*)(Kb + kr * LDT + kc) = rk[0];
    *(u4*)(Kb + (kr + 32) * LDT + kc) = rk[1];
#pragma unroll
    for (int e = 0; e < 4; e++) {
      unsigned a = rv[0][e], c2 = rv[1][e];
      *(unsigned*)(Vb + (dg * 8 + 2 * e) * LDT + 2 * kp) = (a & 0xffffu) | (c2 << 16);
      *(unsigned*)(Vb + (dg * 8 + 2 * e + 1) * LDT + 2 * kp) = (a >> 16) | (c2 & 0xffff0000u);
    }
  };
  gload(rkA, rvA, 0);
  gload(rkB, rvB, 1);
  swrite(rkA, rvA, 0);
  __syncthreads();
  const int qlo = 64 * qb + 32 * rb;
  const int qpos = qlo + r;
  auto tile_body = [&](int kt, u4 (&rkL)[2], u4 (&rvL)[2], u4 (&rkW)[2], u4 (&rvW)[2]) {
    if (kt + 2 < ntile) gload(rkL, rvL, kt + 2);
    const u16* Kb = sm + (kt & 1) * 2 * 64 * LDT;
    const u16* Vb = Kb + 64 * LDT;
    bool skip = false;
    int kpos0 = 0;
    const bool masked = (MODE == 1) && latent && kt >= 4;
    if (masked) {
      kpos0 = 64 * (jlo + kt - 4);
      if (kpos0 > qlo + 31 + 128 || kpos0 + 63 < qlo - 128) skip = true;
    }
    if (!skip) {
      u4 pb[2][2];
      f16 st[2];
#pragma unroll
      for (int kb = 0; kb < 2; kb++) {
        st[kb] = negm;
#pragma unroll
        for (int s = 0; s < NS; s++) {
          bf8 a = *(const bf8*)(Kb + (32 * kb + swz23(r)) * LDT + koff + 16 * s + 8 * hh);
          st[kb] = __builtin_amdgcn_mfma_f32_32x32x16_bf16(a, qf[s], st[kb], 0, 0, 0);
        }
      }
      if (masked) {
#pragma unroll
        for (int kb = 0; kb < 2; kb++)
#pragma unroll
          for (int i = 0; i < 16; i++) {
            int kpos = kpos0 + 32 * kb + (i & 7) + 8 * hh + 16 * (i >> 3);
            int dd = qpos - kpos;
            if (dd > 128 || dd < -128) st[kb][i] = -1e30f;
          }
      }
      float mt = st[0][0];
#pragma unroll
      for (int i = 1; i < 16; i++) mt = fmaxf(mt, st[0][i]);
#pragma unroll
      for (int i = 0; i < 16; i++) mt = fmaxf(mt, st[1][i]);
      mt = xhalf_max(mt);
      const bool first = kt == 0;
      if (first || __any(mt > 8.f)) {
        const float dm = first ? mt : fmaxf(mt, 0.f);
        const float al = first ? 1.f : fexp2(-dm);
        m += dm;
        lacc[0] *= al;
#pragma unroll
        for (int i = 0; i < 16; i++) { O[0][i] *= al; O[1][i] *= al; st[0][i] -= dm; st[1][i] -= dm; negm[i] = -m; }
      }
#pragma unroll
      for (int kb = 0; kb < 2; kb++) {
#pragma unroll
        for (int i = 0; i < 16; i++) st[kb][i] = fexp2(st[kb][i]);
#pragma unroll
        for (int s = 0; s < 2; s++)
#pragma unroll
          for (int q = 0; q < 4; q++) pb[kb][s][q] = pk2(st[kb][8 * s + 2 * q], st[kb][8 * s + 2 * q + 1]);
      }
#pragma unroll
      for (int kb = 0; kb < 2; kb++)
#pragma unroll
        for (int s = 0; s < 2; s++)
          lacc = __builtin_amdgcn_mfma_f32_32x32x16_bf16(ones, __builtin_bit_cast(bf8, pb[kb][s]), lacc, 0, 0, 0);
#pragma unroll
      for (int dt = 0; dt < 2; dt++)
#pragma unroll
        for (int kb = 0; kb < 2; kb++)
#pragma unroll
          for (int s = 0; s < 2; s++) {
            bf8 a = *(const bf8*)(Vb + (32 * dt + r) * LDT + 32 * kb + 16 * s + 8 * hh);
            O[dt] = __builtin_amdgcn_mfma_f32_32x32x16_bf16(a, __builtin_bit_cast(bf8, pb[kb][s]), O[dt], 0, 0, 0);
          }
    }
    if (kt + 1 < ntile) swrite(rkW, rvW, (kt + 1) & 1);
    __syncthreads();
  };
  for (int kt = 0; kt < ntile; kt += 2) {
    tile_body(kt, rkA, rvA, rkB, rvB);
    if (kt + 1 < ntile) tile_body(kt + 1, rkB, rvB, rkA, rvA);
  }
  if (MODE == 0) {
    const float lam_init = 0.8f - 0.6f * __expf(-0.3f * (float)l);
    float d0 = 0.f, d1 = 0.f;
    for (int i = 0; i < 32; i++) {
      d0 += p.lam_q[(l * 2 + 0) * 32 + i] * p.lam_k[(l * 2 + 0) * 32 + i];
      d1 += p.lam_q[(l * 2 + 1) * 32 + i] * p.lam_k[(l * 2 + 1) * 32 + i];
    }
    const float lam = __expf(d0) - __expf(d1) + lam_init;
    const float inv = (pl == 0 ? 1.f : lam) / lacc[0];
    float* xch = (float*)sm + rb * (32 * 64);
    if (pl == 1) {
#pragma unroll
      for (int dt = 0; dt < 2; dt++)
#pragma unroll
        for (int i = 0; i < 16; i++) xch[(dt * 16 + i) * 64 + lane] = O[dt][i] * inv;
    }
    __syncthreads();
    if (pl == 0) {
      float ss = 0.f;
#pragma unroll
      for (int dt = 0; dt < 2; dt++)
#pragma unroll
        for (int i = 0; i < 16; i++) { float o = O[dt][i] * inv - xch[(dt * 16 + i) * 64 + lane]; O[dt][i] = o; ss += o * o; }
      ss = xhalf_sum(ss);
      const float rs = rsqrtf(ss * (1.f / 64.f) + 1e-5f) * (1.f - lam_init);
      const float* gs = p.subln + l * 256 + hd * 64;
#pragma unroll
      for (int dt = 0; dt < 2; dt++)
#pragma unroll
        for (int i4 = 0; i4 < 4; i4++) {
          const int dv = 32 * dt + 8 * i4 + 4 * hh;
          u2 ov;
          ov[0] = pk2(O[dt][4 * i4 + 0] * rs * gs[dv + 0], O[dt][4 * i4 + 1] * rs * gs[dv + 1]);
          ov[1] = pk2(O[dt][4 * i4 + 2] * rs * gs[dv + 2], O[dt][4 * i4 + 3] * rs * gs[dv + 3]);
          *(u2*)(ACD + qrow * PACD + hd * 64 + dv) = ov;
        }
    }
    __syncthreads();
  } else {
    const float sk = p.win_sink[l * 4 + hd * 2 + pl] * LOG2E;
    const float lt = lacc[0] + fexp2(sk - m);
    const float inv = 1.f / lt;
#pragma unroll
    for (int dt = 0; dt < 2; dt++)
#pragma unroll
      for (int i4 = 0; i4 < 4; i4++) {
        const int dv = 32 * dt + 8 * i4 + 4 * hh;
        u2 ov;
        ov[0] = pk2(O[dt][4 * i4 + 0] * inv, O[dt][4 * i4 + 1] * inv);
        ov[1] = pk2(O[dt][4 * i4 + 2] * inv, O[dt][4 * i4 + 3] * inv);
        *(u2*)(ACD + qrow * PACD + 1536 + (hd * 2 + pl) * 64 + dv) = ov;
      }
  }
}

__device__ __forceinline__ void attnA2_item(const Params& p, int l, int item, u16* sm) {
  const int tid = ltid(), lane = tid & 63, w = __builtin_amdgcn_readfirstlane(tid >> 6), r = lane & 31, hh = lane >> 5;
  u16* ACD = (u16*)(p.ws + OFF_ACD);
  int b, hd, qrow0, ntile;
  if (item < 1024) { b = item >> 9; hd = (item >> 7) & 3; qrow0 = b * TT + CTX + 128 * (item & 127); ntile = 260; }
  else { int j = item - 1024; b = j >> 3; hd = (j >> 1) & 3; qrow0 = b * TT + 128 * (j & 1); ntile = 4; }
  const int kcol = 256 + hd * 64, vcol = 512 + hd * 64;
  const size_t qrow = (size_t)qrow0 + 32 * w + r;
  bf8 qf[2][2];
#pragma unroll
  for (int pl = 0; pl < 2; pl++)
#pragma unroll
    for (int s = 0; s < 2; s++) qf[pl][s] = *(const bf8*)(ACD + qrow * PACD + hd * 64 + 32 * pl + 16 * s + 8 * hh);
  f16 O[2][2];
  float m[2] = {0.f, 0.f}, lsum[2] = {0.f, 0.f};
#pragma unroll
  for (int pl = 0; pl < 2; pl++)
#pragma unroll
    for (int dt = 0; dt < 2; dt++)
#pragma unroll
      for (int i = 0; i < 16; i++) O[pl][dt][i] = 0.f;
  u4 rkA[2], rvA[2], rkB[2], rvB[2];
  const int kr = tid >> 3, kc = (tid & 7) * 8;
  const int kp = tid >> 3, dg = tid & 7;
  auto gload = [&](u4 (&rk)[2], u4 (&rv)[2], int kt) {
    const size_t k0 = (size_t)b * TT + 64 * kt;
    rk[0] = *(const u4*)(ACD + (k0 + kr) * PACD + kcol + kc);
    rk[1] = *(const u4*)(ACD + (k0 + kr + 32) * PACD + kcol + kc);
    rv[0] = *(const u4*)(ACD + (k0 + 2 * kp) * PACD + vcol + dg * 8);
    rv[1] = *(const u4*)(ACD + (k0 + 2 * kp + 1) * PACD + vcol + dg * 8);
  };
  auto swrite = [&](const u4 (&rk)[2], const u4 (&rv)[2], int buf) {
    u16* Kb = sm + buf * 2 * 64 * LDT;
    u16* Vb = Kb + 64 * LDT;
    *(u4*)(Kb + kr * LDT + kc) = rk[0];
    *(u4*)(Kb + (kr + 32) * LDT + kc) = rk[1];
#pragma unroll
    for (int e = 0; e < 4; e++) {
      unsigned a = rv[0][e], c2 = rv[1][e];
      *(unsigned*)(Vb + (dg * 8 + 2 * e) * LDT + 2 * kp) = (a & 0xffffu) | (c2 << 16);
      *(unsigned*)(Vb + (dg * 8 + 2 * e + 1) * LDT + 2 * kp) = (a >> 16) | (c2 & 0xffff0000u);
    }
  };
  gload(rkA, rvA, 0);
  gload(rkB, rvB, 1);
  swrite(rkA, rvA, 0);
  __syncthreads();
  auto tile_body = [&](int kt, u4 (&rkL)[2], u4 (&rvL)[2], u4 (&rkW)[2], u4 (&rvW)[2]) {
    if (kt + 2 < ntile) gload(rkL, rvL, kt + 2);
    const u16* Kb = sm + (kt & 1) * 2 * 64 * LDT;
    const u16* Vb = Kb + 64 * LDT;
    const bool first = kt == 0;
#pragma unroll
    for (int pl = 0; pl < 2; pl++) {
      u4 pb[2][2];
      f16 st[2];
#pragma unroll
      for (int kb = 0; kb < 2; kb++) {
#pragma unroll
        for (int i = 0; i < 16; i++) st[kb][i] = 0.f;
#pragma unroll
        for (int s = 0; s < 2; s++) {
          bf8 a = *(const bf8*)(Kb + (32 * kb + swz23(r)) * LDT + 32 * pl + 16 * s + 8 * hh);
          st[kb] = __builtin_amdgcn_mfma_f32_32x32x16_bf16(a, qf[pl][s], st[kb], 0, 0, 0);
        }
      }
      float mt = st[0][0];
#pragma unroll
      for (int i = 1; i < 16; i++) mt = fmaxf(mt, st[0][i]);
#pragma unroll
      for (int i = 0; i < 16; i++) mt = fmaxf(mt, st[1][i]);
      mt = xhalf_max(mt);
      if (first || __any(mt > m[pl] + 8.f)) {
        const float mn = first ? mt : fmaxf(m[pl], mt);
        const float al = first ? 1.f : fexp2(m[pl] - mn);
        m[pl] = mn; lsum[pl] *= al;
#pragma unroll
        for (int i = 0; i < 16; i++) { O[pl][0][i] *= al; O[pl][1][i] *= al; }
      }
      const float mm = m[pl];
      float ls = 0.f;
#pragma unroll
      for (int kb = 0; kb < 2; kb++) {
#pragma unroll
        for (int i = 0; i < 16; i++) { float e = fexp2(st[kb][i] - mm); st[kb][i] = e; ls += e; }
#pragma unroll
        for (int s = 0; s < 2; s++)
#pragma unroll
          for (int q = 0; q < 4; q++) pb[kb][s][q] = pk2(st[kb][8 * s + 2 * q], st[kb][8 * s + 2 * q + 1]);
      }
      lsum[pl] += ls;
#pragma unroll
      for (int dt = 0; dt < 2; dt++)
#pragma unroll
        for (int kb = 0; kb < 2; kb++)
#pragma unroll
          for (int s = 0; s < 2; s++) {
            bf8 a = *(const bf8*)(Vb + (32 * dt + r) * LDT + 32 * kb + 16 * s + 8 * hh);
            O[pl][dt] = __builtin_amdgcn_mfma_f32_32x32x16_bf16(a, __builtin_bit_cast(bf8, pb[kb][s]), O[pl][dt], 0, 0, 0);
          }
      __builtin_amdgcn_sched_barrier(0);
    }
    if (kt + 1 < ntile) swrite(rkW, rvW, (kt + 1) & 1);
    __syncthreads();
  };
  for (int kt = 0; kt < ntile; kt += 2) {
    tile_body(kt, rkA, rvA, rkB, rvB);
    tile_body(kt + 1, rkB, rvB, rkA, rvA);
  }
  const float lam_init = 0.8f - 0.6f * __expf(-0.3f * (float)l);
  float d0 = 0.f, d1 = 0.f;
  for (int i = 0; i < 32; i++) {
    d0 += p.lam_q[(l * 2 + 0) * 32 + i] * p.lam_k[(l * 2 + 0) * 32 + i];
    d1 += p.lam_q[(l * 2 + 1) * 32 + i] * p.lam_k[(l * 2 + 1) * 32 + i];
  }
  const float lam = __expf(d0) - __expf(d1) + lam_init;
  const float i0 = 1.f / xhalf_sum(lsum[0]);
  const float i1 = lam / xhalf_sum(lsum[1]);
  float ss = 0.f;
#pragma unroll
  for (int dt = 0; dt < 2; dt++)
#pragma unroll
    for (int i = 0; i < 16; i++) { float o = O[0][dt][i] * i0 - O[1][dt][i] * i1; O[0][dt][i] = o; ss += o * o; }
  ss = xhalf_sum(ss);
  const float rs = rsqrtf(ss * (1.f / 64.f) + 1e-5f) * (1.f - lam_init);
  const float* gs = p.subln + l * 256 + hd * 64;
#pragma unroll
  for (int dt = 0; dt < 2; dt++)
#pragma unroll
    for (int i4 = 0; i4 < 4; i4++) {
      const int dv = 32 * dt + 8 * i4 + 4 * hh;
      u2 ov;
      ov[0] = pk2(O[0][dt][4 * i4 + 0] * rs * gs[dv + 0], O[0][dt][4 * i4 + 1] * rs * gs[dv + 1]);
      ov[1] = pk2(O[0][dt][4 * i4 + 2] * rs * gs[dv + 2], O[0][dt][4 * i4 + 3] * rs * gs[dv + 3]);
      *(u2*)(ACD + qrow * PACD + hd * 64 + dv) = ov;
    }
}

__device__ __forceinline__ void phase_m1(const Params& p, int l, unsigned char* smem) {
  const int NP = NR / 16, NC = 260 * 4;
  for (int it = blockIdx.x; it < NP + NC; it += gridDim.x) {
    if (it < NP) prepb_tile(p, l, it, (float*)smem);
    else retc1_item(p, l, it - NP, (float*)smem);
  }
}
__device__ __forceinline__ unsigned xb_xcc_id();
__device__ __forceinline__ void phase_m2(const Params& p, int l, unsigned char* smem) {
  __shared__ int s_item;
  unsigned* ctr = (unsigned*)(p.ws + OFF_CTR) + 16 * l;
  const int N0 = 4160, N1 = N0 + 1040, N2 = N1 + 128;
  for (;;) {
    if (threadIdx.x == 0) s_item = (int)atomicAdd(ctr, 1u);
    __syncthreads();
    const int it = s_item;
    __syncthreads();
    if (it >= N2) break;
    if (it < N0) rwkv_s1_item(p, it, (u16*)smem);
    else if (it < N1) attn_item<1>(p, l, it - N0, (u16*)smem);
    else retc2_item(p, l, it - N1);
  }
}
__device__ __forceinline__ void phase_m2b(const Params& p, int l, unsigned char* smem) {
  __shared__ int s_item2;
  unsigned* ctr = (unsigned*)(p.ws + OFF_CTR) + 16 * l;
  for (;;) {
    if (threadIdx.x == 0) s_item2 = (int)atomicAdd(ctr + 1, 1u);
    __syncthreads();
    const int it = s_item2;
    __syncthreads();
    if (it >= 8) break;
    rwkv_s2_item(p, it);
  }
  const int x0 = (int)(xb_xcc_id() & 7u);
  for (int dx = 0; dx < 8; dx++) {
    const int x = (x0 + dx) & 7;
    for (;;) {
      if (threadIdx.x == 0) s_item2 = (int)atomicAdd(ctr + 2 + x, 1u);
      __syncthreads();
      const int j = s_item2;
      __syncthreads();
      if (j >= 130) break;
      attnA2_item(p, l, j < 128 ? x * 128 + j : 1024 + x * 2 + (j - 128), (u16*)smem);
    }
  }
}
__device__ __forceinline__ void phase_m3(const Params& p, int l, unsigned char* smem) {
  const int NF = 2080, NC = 260 * 4;
  for (int it = blockIdx.x; it < NF + NC; it += gridDim.x) {
    if (it < NF) rwkv_s3_item(p, l, it, (u16*)smem);
    else retc3_item(p, l, it - NF, (u16*)smem);
  }
}

__device__ __forceinline__ void phase_merge(const Params& p, int l, unsigned char* smem) {
  const u16* H = (const u16*)(p.ws + OFF_H);
  const u16* winT = (const u16*)(p.ws + OFF_WA);
  const u16* wbrT = winT + (size_t)WINC * DM;
  const u16* ACD = (const u16*)(p.ws + OFF_ACD);
  const u16* GB = (const u16*)(p.ws + OFF_GB);
  u16* M = (u16*)(p.ws + OFF_M);
  GemmPipe1<2> pp;
  auto yptr = [&](int n, const u16*& yp, int& yl) {
    if (n == 0) { yp = ACD; yl = PACD; } else if (n == 1) { yp = GB; yl = 256; }
    else if (n == 2) { yp = ACD + 1280; yl = PACD; } else { yp = ACD + 1536; yl = PACD; }
  };
  int mt, nt;
  bool have = gemm_tile_of(0, 8, mt, nt);
  if (have) gemm_prefetch1<2>(pp, H + (size_t)mt * 128 * DM, DM, winT + ((size_t)3200 + nt * 128) * DM, DM);
  for (int kk = 0; have; kk++) {
    const int m0 = mt * 128, n0 = nt * 128;
    have = gemm_tile_of(kk + 1, 8, mt, nt);
    unsigned mpk[2][2][8];
#pragma unroll
    for (int mi = 0; mi < 2; mi++)
#pragma unroll
      for (int ni = 0; ni < 2; ni++)
#pragma unroll
        for (int i = 0; i < 8; i++) mpk[mi][ni][i] = 0u;
#pragma unroll 1
    for (int n = 0; n < 4; n++) {
      const u16* yp; int yl;
      yptr(n, yp, yl);
      unsigned sg[2][2][8];
      {
        f16 gacc[2][2];
        zero_acc<2>(gacc);
        gemm_main1<2>(gacc, pp, H + (size_t)m0 * DM, DM, winT + ((size_t)3200 + n * DM + n0) * DM, DM, DM, (u16*)smem);
        gemm_prefetch1<2>(pp, yp + (size_t)m0 * yl, yl, wbrT + ((size_t)n * DM + n0) * 256, 256);
#pragma unroll
        for (int mi = 0; mi < 2; mi++)
#pragma unroll
          for (int ni = 0; ni < 2; ni++)
#pragma unroll
            for (int i = 0; i < 8; i++) sg[mi][ni][i] = pk2(fsigmoid(gacc[mi][ni][2 * i]), fsigmoid(gacc[mi][ni][2 * i + 1]));
      }
      f16 yacc[2][2];
      zero_acc<2>(yacc);
      gemm_main1<2>(yacc, pp, yp + (size_t)m0 * yl, yl, wbrT + ((size_t)n * DM + n0) * 256, 256, 256, (u16*)smem);
      {
        int m0n = m0, n0n = n0, nn = n + 1;
        bool hv = true;
        if (nn == 4) { hv = have; m0n = mt * 128; n0n = nt * 128; nn = 0; }
        if (hv) gemm_prefetch1<2>(pp, H + (size_t)m0n * DM, DM, winT + ((size_t)3200 + nn * DM + n0n) * DM, DM);
      }
#pragma unroll
      for (int mi = 0; mi < 2; mi++)
#pragma unroll
        for (int ni = 0; ni < 2; ni++)
#pragma unroll
          for (int i = 0; i < 8; i++) {
            const float a = lo16(mpk[mi][ni][i]) + lo16(sg[mi][ni][i]) * yacc[mi][ni][2 * i];
            const float c2 = hi16(mpk[mi][ni][i]) + hi16(sg[mi][ni][i]) * yacc[mi][ni][2 * i + 1];
            mpk[mi][ni][i] = pk2(a, c2);
          }
    }
    f16 macc[2][2];
#pragma unroll
    for (int mi = 0; mi < 2; mi++)
#pragma unroll
      for (int ni = 0; ni < 2; ni++)
#pragma unroll
        for (int i = 0; i < 8; i++) { macc[mi][ni][2 * i] = lo16(mpk[mi][ni][i]); macc[mi][ni][2 * i + 1] = hi16(mpk[mi][ni][i]); }
    gemm_epi<2>(macc, (float*)smem, [&](int row, int c8, const float* e) {
      store8(M + (size_t)(m0 + row) * DM + n0 + c8, e);
    });
  }
}

template <int ACT>
__device__ __forceinline__ void phase_gemm(const u16* A, const u16* WT, u16* OUT, int N, int K, unsigned char* smem) {
  const int ntn = N >> 7;
  GemmPipe<2> pp;
  int mt, nt;
  bool have = gemm_tile_of(0, ntn, mt, nt);
  if (have) gemm_prefetch<2>(pp, A + (size_t)mt * 128 * K, K, WT + (size_t)nt * 128 * K, K);
  for (int kk = 0; have; kk++) {
    const int m0 = mt * 128, n0 = nt * 128;
    f16 acc[2][2];
    zero_acc<2>(acc);
    gemm_main<2>(acc, pp, A + (size_t)m0 * K, K, WT + (size_t)n0 * K, K, K, (u16*)smem);
    have = gemm_tile_of(kk + 1, ntn, mt, nt);
    if (have) gemm_prefetch<2>(pp, A + (size_t)mt * 128 * K, K, WT + (size_t)nt * 128 * K, K);
    gemm_epi<2>(acc, (float*)smem, [&](int row, int c8, const float* e) {
      float v[8];
#pragma unroll
      for (int i = 0; i < 8; i++) { float x = e[i]; if (ACT == 1) { x = fmaxf(x, 0.f); x = x * x; } v[i] = x; }
      store8(OUT + (size_t)(m0 + row) * N + n0 + c8, v);
    });
  }
}

__device__ __forceinline__ unsigned xb_xcc_id() { return (unsigned)__builtin_amdgcn_s_getreg((3 << 11) | 20) & 0xFu; }

constexpr int PH_PER_LAYER = 11;
constexpr int NPHASE = 2 + DEPTH * PH_PER_LAYER;

__device__ __forceinline__ void run_phase(const Params& p, int ph, unsigned char* smem) {
  if (ph == 0) { phase_pro(p, smem); return; }
  if (ph == 1) { phase_rows(p, 0, 0); return; }
  const int l = (ph - 2) / PH_PER_LAYER, s = (ph - 2) % PH_PER_LAYER;
  unsigned char* ws = p.ws;
  switch (s) {
    case 0: phase_gemm1(p, l, smem); break;
    case 1: phase_m1(p, l, smem); break;
    case 2: phase_m2(p, l, smem); break;
    case 3: phase_m2b(p, l, smem); break;
    case 4: phase_m3(p, l, smem); break;
    case 5: phase_merge(p, l, smem); break;
    case 6: phase_gemm<0>((const u16*)(ws + OFF_M), (const u16*)(ws + OFF_WA) + (size_t)WINC * DM + (size_t)4 * DM * 256,
                          (u16*)(ws + OFF_MO), DM, DM, smem); break;
    case 7: phase_rows(p, l, 1); break;
    case 8: phase_gemm<1>((const u16*)(ws + OFF_H), (const u16*)(ws + OFF_WM), (u16*)(ws + OFF_U), DFF, DM, smem); break;
    case 9: phase_gemm<0>((const u16*)(ws + OFF_U), (const u16*)(ws + OFF_WM) + (size_t)DFF * DM, (u16*)(ws + OFF_DN), DM, DFF, smem); break;
    case 10: phase_rows(p, l, 2); if (l + 1 < DEPTH) wconv_layer(p, l + 1, smem); break;
  }
}

__global__ void __launch_bounds__(256, 2) mega_kernel(Params p) {
  __shared__ __attribute__((aligned(16))) unsigned char smem[SMEM_BYTES];
  cg::grid_group grid = cg::this_grid();
  for (int ph = 0; ph < NPHASE; ph++) {
    run_phase(p, ph, smem);
    if (ph + 1 < NPHASE) {
      grid.sync();
    }
  }
}

#if MULTI_LAUNCH
__global__ void __launch_bounds__(256, 2) phase_kernel(Params p, int ph) {
  __shared__ __attribute__((aligned(16))) unsigned char smem[SMEM_BYTES];
  run_phase(p, ph, smem);
}
#endif

extern "C" void kernel_launch(void* const* d_in, const int* in_sizes, int n_in, void* d_out, int out_size, void* d_ws,
                              size_t ws_size, hipStream_t stream) {
  Params p{};
  const float** pp = (const float**)&p;
  for (int i = 0; i < 32; i++) pp[i] = (const float*)d_in[i];
  p.out = (float*)d_out;
  p.ws = (unsigned char*)d_ws;
#if MULTI_LAUNCH
  hipMemsetAsync((unsigned char*)d_ws + OFF_CTR, 0, 256, stream);
  for (int ph = 0; ph < NPHASE; ph++) phase_kernel<<<dim3(512), dim3(256), 0, stream>>>(p, ph);
#else
  static int grid_blocks = 0;
  if (!grid_blocks) {
    int dev = 0, cus = 0, per_cu = 0;
    hipGetDevice(&dev);
    hipDeviceGetAttribute(&cus, hipDeviceAttributeMultiprocessorCount, dev);
    hipOccupancyMaxActiveBlocksPerMultiprocessor(&per_cu, mega_kernel, 256, 0);
    if (per_cu > 2) per_cu = 2;
    if (per_cu < 1) per_cu = 1;
    grid_blocks = cus * per_cu;
  }
  (void)hipMemsetAsync((unsigned char*)d_ws + OFF_CTR, 0, 4096, stream);
  void* args[] = {&p};
  hipError_t e = hipLaunchCooperativeKernel((void*)mega_kernel, dim3(grid_blocks), dim3(256), args, 0, stream);
  if (e != hipSuccess) fprintf(stderr, "cooperative launch failed: %s (grid %d)\n", hipGetErrorString(e), grid_blocks);
#endif
}
```

```cpp
#include <hip/hip_runtime.h>
#include <hip/hip_cooperative_groups.h>
#include <stdint.h>
#include <stdio.h>
namespace cg = cooperative_groups;

typedef unsigned short u16;
typedef __attribute__((ext_vector_type(8))) __bf16 bf8;
typedef __attribute__((ext_vector_type(2))) __bf16 bf2;
typedef __attribute__((ext_vector_type(2))) float f2;
typedef __attribute__((ext_vector_type(4))) float f4;
typedef __attribute__((ext_vector_type(16))) float f16;
typedef __attribute__((ext_vector_type(4))) unsigned u4;
typedef __attribute__((ext_vector_type(2))) unsigned u2;

#ifndef MULTI_LAUNCH
#define MULTI_LAUNCH 0
#endif

constexpr int DM = 1024, NB = 2, SEQ = 16384, CTX = 256, TT = SEQ + CTX, NR = NB * TT, DEPTH = 4;
constexpr int WINC = 7296, DFF = 4096;
constexpr int PACD = 2048, PCB = 1152;
constexpr size_t MiB = 1u << 20;
constexpr size_t OFF_CTXRES = 0, OFF_MOD = 2 * MiB, OFF_CTR = 2 * MiB + 512 * 1024, OFF_TAB = 3 * MiB, OFF_WA = 6 * MiB,
                 OFF_H = 25 * MiB, OFF_ACD = 90 * MiB, OFF_CB = 220 * MiB, OFF_SCAN = 294 * MiB, OFF_GB = 441 * MiB,
                 OFF_DS = 458 * MiB, OFF_SIN = 475 * MiB, OFF_WM = 484 * MiB,
                 OFF_M = OFF_SCAN, OFF_MO = OFF_CB, OFF_U = 90 * MiB, OFF_DN = 360 * MiB;
constexpr size_t ARR = (size_t)NR * 256;
constexpr float LOG2E = 1.4426950408889634f;
constexpr int LDT = 72;
constexpr int EPS = 132;
constexpr int SMEM_BYTES = 2 * 2 * 128 * LDT * 2 + 5376;

struct Params {
  const float *x, *c, *ctx, *c_ctx, *ada_w, *ada_b, *n_pre_mix, *n_post_mix, *n_pre_mlp, *n_post_mlp, *w_in,
      *lam_q, *lam_k, *subln, *mu, *w0, *w2, *a0, *a2, *g2, *rkk, *rka, *rrk, *lnx_g, *lnx_b, *ret_decay, *ret_gn,
      *win_sink, *w_branch, *w_out, *w_up, *w_down;
  float* out;
  unsigned char* ws;
};

__device__ __forceinline__ float bf2f(u16 h) { return __uint_as_float(((unsigned)h) << 16); }
__device__ __forceinline__ unsigned pk2(float a, float b) {
  bf2 r = __builtin_convertvector((f2){a, b}, bf2);
  return __builtin_bit_cast(unsigned, r);
}
__device__ __forceinline__ u16 f2bf(float a) { return (u16)(pk2(a, 0.f) & 0xffffu); }
__device__ __forceinline__ float lo16(unsigned x) { return __uint_as_float(x << 16); }
__device__ __forceinline__ float hi16(unsigned x) { return __uint_as_float(x & 0xffff0000u); }
__device__ __forceinline__ void store8(u16* dst, const float* v) {
  u4 o;
  o[0] = pk2(v[0], v[1]); o[1] = pk2(v[2], v[3]); o[2] = pk2(v[4], v[5]); o[3] = pk2(v[6], v[7]);
  *(u4*)dst = o;
}
__device__ __forceinline__ float wsum(float x) {
  x += __builtin_bit_cast(float, __builtin_amdgcn_update_dpp(0, __builtin_bit_cast(int, x), 0xB1, 0xF, 0xF, true));
  x += __builtin_bit_cast(float, __builtin_amdgcn_update_dpp(0, __builtin_bit_cast(int, x), 0x4E, 0xF, 0xF, true));
  x += __builtin_bit_cast(float, __builtin_amdgcn_update_dpp(0, __builtin_bit_cast(int, x), 0x141, 0xF, 0xF, true));
  x += __builtin_bit_cast(float, __builtin_amdgcn_update_dpp(0, __builtin_bit_cast(int, x), 0x140, 0xF, 0xF, true));
  x += __builtin_bit_cast(float, __builtin_amdgcn_update_dpp(0, __builtin_bit_cast(int, x), 0x142, 0xA, 0xF, false));
  x += __builtin_bit_cast(float, __builtin_amdgcn_update_dpp(0, __builtin_bit_cast(int, x), 0x143, 0xC, 0xF, false));
  return __builtin_bit_cast(float, __builtin_amdgcn_readlane(__builtin_bit_cast(int, x), 63));
}
__device__ __forceinline__ float xhalf_max(float v) {
  auto r = __builtin_amdgcn_permlane32_swap(__float_as_uint(v), __float_as_uint(v), false, false);
  return fmaxf(__uint_as_float(r[0]), __uint_as_float(r[1]));
}
__device__ __forceinline__ float xhalf_sum(float v) {
  auto r = __builtin_amdgcn_permlane32_swap(__float_as_uint(v), __float_as_uint(v), false, false);
  return __uint_as_float(r[0]) + __uint_as_float(r[1]);
}
__device__ __forceinline__ int ltid() { int t = threadIdx.x; asm volatile("" : "+v"(t)); return t; }
__device__ __forceinline__ float fexp2(float x) { return __builtin_amdgcn_exp2f(x); }
__device__ __forceinline__ float fsigmoid(float x) { return __builtin_amdgcn_rcpf(1.f + fexp2(-x * LOG2E)); }
__device__ __forceinline__ int swz23(int r) { return (r & 0x13) | ((r & 4) << 1) | ((r & 8) >> 1); }

__device__ __forceinline__ float* xrow(const Params& p, int row) {
  int b = row >= TT ? 1 : 0;
  int t = row - b * TT;
  if (t < CTX) return (float*)(p.ws + OFF_CTXRES) + (size_t)(b * CTX + t) * DM;
  return p.out + (size_t)(b * SEQ + t - CTX) * DM;
}
__device__ __forceinline__ const float* xrow_in(const Params& p, int row) {
  int b = row >= TT ? 1 : 0;
  int t = row - b * TT;
  if (t < CTX) return p.ctx + (size_t)(b * CTX + t) * DM;
  return p.x + (size_t)(b * SEQ + t - CTX) * DM;
}
__device__ __forceinline__ const float* modrow(const Params& p, int layer, int row) {
  int b = row >= TT ? 1 : 0;
  int t = row - b * TT;
  int which = t < CTX ? 2 : b;
  return (const float*)(p.ws + OFF_MOD) + (size_t)(layer * 3 + which) * 6 * DM;
}

__device__ __forceinline__ bool gemm_tile_of(int k, int ntn, int& mt, int& nt) {
  const int x = blockIdx.x & 7, lb = blockIdx.x >> 3, nlb = gridDim.x >> 3;
  const int mstart = x * 32 + (x < 4 ? x : 4), mcount = 32 + (x < 4 ? 1 : 0);
  const int j = lb + k * nlb;
  if (j >= mcount * ntn) return false;
  int mg, rm, jj;
  if (j < 32 * ntn) { mg = j / (8 * ntn); rm = 8; jj = j - mg * 8 * ntn; }
  else { mg = 4; rm = 1; jj = j - 32 * ntn; }
  nt = jj / rm;
  mt = mstart + mg * 8 + (jj - nt * rm);
  return true;
}

template <int NI>
struct GemmPipe { u4 ra0[4], rb0[2 * NI], ra1[4], rb1[2 * NI]; };

template <int NI>
__device__ __forceinline__ void gemm_prefetch(GemmPipe<NI>& pp, const u16* __restrict__ A, int lda,
                                              const u16* __restrict__ B, int ldb) {
  const int tid = ltid();
  const int crow = tid >> 3, ckc = (tid & 7) * 8;
  const u16* Ap = A + (size_t)crow * lda + ckc;
  const u16* Bp = B + (size_t)crow * ldb + ckc;
  const size_t astep = (size_t)32 * lda, bstep = (size_t)32 * ldb;
#pragma unroll
  for (int i = 0; i < 4; i++) { pp.ra0[i] = *(const u4*)(Ap + i * astep); pp.ra1[i] = *(const u4*)(Ap + i * astep + 64); }
#pragma unroll
  for (int i = 0; i < 2 * NI; i++) { pp.rb0[i] = *(const u4*)(Bp + i * bstep); pp.rb1[i] = *(const u4*)(Bp + i * bstep + 64); }
}

template <int NI>
__device__ __forceinline__ void gemm_main(f16 (&acc)[2][NI], GemmPipe<NI>& pp, const u16* __restrict__ A, int lda,
                                          const u16* __restrict__ B, int ldb, int K, u16* sm) {
  const int tid = ltid(), lane = tid & 63, wid = tid >> 6, wm = wid >> 1, wn = wid & 1;
  const int r = lane & 31, hh = lane >> 5;
  u16* sa = sm;
  u16* sb = sm + 2 * 128 * LDT;
  const int nk = K >> 6;
  const int crow = tid >> 3, ckc = (tid & 7) * 8;
  const u16* Ap = A + (size_t)crow * lda + ckc;
  const u16* Bp = B + (size_t)crow * ldb + ckc;
  const size_t astep = (size_t)32 * lda, bstep = (size_t)32 * ldb;
  auto gload = [&](u4 (&ra)[4], u4 (&rb)[2 * NI], int kt) {
#pragma unroll
    for (int i = 0; i < 4; i++) ra[i] = *(const u4*)(Ap + i * astep + kt * 64);
#pragma unroll
    for (int i = 0; i < 2 * NI; i++) rb[i] = *(const u4*)(Bp + i * bstep + kt * 64);
  };
  auto swrite = [&](const u4 (&ra)[4], const u4 (&rb)[2 * NI], int buf) {
    const int nb = buf * 128 * LDT;
#pragma unroll
    for (int i = 0; i < 4; i++) *(u4*)(sa + nb + (crow + 32 * i) * LDT + ckc) = ra[i];
#pragma unroll
    for (int i = 0; i < 2 * NI; i++) *(u4*)(sb + nb + (crow + 32 * i) * LDT + ckc) = rb[i];
  };
  auto compute = [&](int buf) {
    const u16* a0 = sa + buf * 128 * LDT + (64 * wm + r) * LDT + 8 * hh;
    const u16* b0 = sb + buf * 128 * LDT + (32 * NI * wn + r) * LDT + 8 * hh;
#pragma unroll
    for (int s = 0; s < 4; s++) {
      bf8 af[2], bfr[NI];
#pragma unroll
      for (int mi = 0; mi < 2; mi++) af[mi] = *(const bf8*)(a0 + mi * 32 * LDT + 16 * s);
#pragma unroll
      for (int ni = 0; ni < NI; ni++) bfr[ni] = *(const bf8*)(b0 + ni * 32 * LDT + 16 * s);
#pragma unroll
      for (int mi = 0; mi < 2; mi++)
#pragma unroll
        for (int ni = 0; ni < NI; ni++)
          acc[mi][ni] = __builtin_amdgcn_mfma_f32_32x32x16_bf16(af[mi], bfr[ni], acc[mi][ni], 0, 0, 0);
    }
  };
  swrite(pp.ra0, pp.rb0, 0);
  __syncthreads();
  for (int kt = 0; kt < nk; kt += 2) {
    if (kt + 2 < nk) gload(pp.ra0, pp.rb0, kt + 2);
    compute(0);
    swrite(pp.ra1, pp.rb1, 1);
    __syncthreads();
    if (kt + 3 < nk) gload(pp.ra1, pp.rb1, kt + 3);
    compute(1);
    if (kt + 2 < nk) swrite(pp.ra0, pp.rb0, 0);
    __syncthreads();
  }
}

template <int NI>
struct GemmPipe1 { u4 ra[4], rb[2 * NI]; };
template <int NI>
__device__ __forceinline__ void gemm_prefetch1(GemmPipe1<NI>& pp, const u16* __restrict__ A, int lda,
                                               const u16* __restrict__ B, int ldb) {
  const int tid = ltid();
  const int crow = tid >> 3, ckc = (tid & 7) * 8;
#pragma unroll
  for (int i = 0; i < 4; i++) pp.ra[i] = *(const u4*)(A + (size_t)(crow + 32 * i) * lda + ckc);
#pragma unroll
  for (int i = 0; i < 2 * NI; i++) pp.rb[i] = *(const u4*)(B + (size_t)(crow + 32 * i) * ldb + ckc);
}
template <int NI>
__device__ __forceinline__ void gemm_main1(f16 (&acc)[2][NI], GemmPipe1<NI>& pp, const u16* __restrict__ A, int lda,
                                           const u16* __restrict__ B, int ldb, int K, u16* sm) {
  const int tid = ltid(), lane = tid & 63, wid = tid >> 6, wm = wid >> 1, wn = wid & 1;
  const int r = lane & 31, hh = lane >> 5;
  u16* sa = sm;
  u16* sb = sm + 2 * 128 * LDT;
  const int nk = K >> 6;
  const int crow = tid >> 3, ckc = (tid & 7) * 8;
  const u16* Ap = A + (size_t)crow * lda + ckc;
  const u16* Bp = B + (size_t)crow * ldb + ckc;
  const size_t astep = (size_t)32 * lda, bstep = (size_t)32 * ldb;
  auto swrite = [&](int buf) {
    const int nb = buf * 128 * LDT;
#pragma unroll
    for (int i = 0; i < 4; i++) *(u4*)(sa + nb + (crow + 32 * i) * LDT + ckc) = pp.ra[i];
#pragma unroll
    for (int i = 0; i < 2 * NI; i++) *(u4*)(sb + nb + (crow + 32 * i) * LDT + ckc) = pp.rb[i];
  };
  swrite(0);
  __syncthreads();
  for (int kt = 0; kt < nk; kt++) {
    if (kt + 1 < nk) {
#pragma unroll
      for (int i = 0; i < 4; i++) pp.ra[i] = *(const u4*)(Ap + i * astep + (kt + 1) * 64);
#pragma unroll
      for (int i = 0; i < 2 * NI; i++) pp.rb[i] = *(const u4*)(Bp + i * bstep + (kt + 1) * 64);
    }
    const u16* a0 = sa + (kt & 1) * 128 * LDT + (64 * wm + r) * LDT + 8 * hh;
    const u16* b0 = sb + (kt & 1) * 128 * LDT + (32 * NI * wn + r) * LDT + 8 * hh;
#pragma unroll
    for (int s = 0; s < 4; s++) {
      bf8 af[2], bfr[NI];
#pragma unroll
      for (int mi = 0; mi < 2; mi++) af[mi] = *(const bf8*)(a0 + mi * 32 * LDT + 16 * s);
#pragma unroll
      for (int ni = 0; ni < NI; ni++) bfr[ni] = *(const bf8*)(b0 + ni * 32 * LDT + 16 * s);
#pragma unroll
      for (int mi = 0; mi < 2; mi++)
#pragma unroll
        for (int ni = 0; ni < NI; ni++)
          acc[mi][ni] = __builtin_amdgcn_mfma_f32_32x32x16_bf16(af[mi], bfr[ni], acc[mi][ni], 0, 0, 0);
    }
    if (kt + 1 < nk) swrite((kt + 1) & 1);
    __syncthreads();
  }
}

template <int NI, class F>
__device__ __forceinline__ void gemm_epi(f16 (&acc)[2][NI], float* ep, F&& f) {
  const int tid = ltid(), lane = tid & 63, wid = tid >> 6, wm = wid >> 1, wn = wid & 1;
  const int r = lane & 31, hh = lane >> 5;
#pragma unroll
  for (int mi = 0; mi < 2; mi++)
#pragma unroll
    for (int ni = 0; ni < NI; ni++)
#pragma unroll
      for (int i = 0; i < 16; i++) {
        int row = 64 * wm + 32 * mi + (i & 3) + 8 * (i >> 2) + 4 * hh;
        int col = 32 * NI * wn + 32 * ni + r;
        ep[row * EPS + col] = acc[mi][ni][i];
      }
  __syncthreads();
  constexpr int CG = 8 * NI;
  for (int u = tid; u < 128 * CG; u += 256) {
    int row = u / CG, c8 = (u % CG) * 8;
    f(row, c8, ep + row * EPS + c8);
  }
  __syncthreads();
}

template <int NI>
__device__ __forceinline__ void zero_acc(f16 (&acc)[2][NI]) {
#pragma unroll
  for (int mi = 0; mi < 2; mi++)
#pragma unroll
    for (int ni = 0; ni < NI; ni++)
#pragma unroll
      for (int i = 0; i < 16; i++) acc[mi][ni][i] = 0.f;
}

__device__ __forceinline__ void wconv_tile(const float* __restrict__ src, u16* __restrict__ dst, int K, int N, int idx, float* tl) {
  const int tid = ltid();
  const int ntn = N >> 6;
  const int kt = idx / ntn, nt = idx - kt * ntn;
  const int k0 = kt * 64, n0 = nt * 64;
  const int a = tid >> 6, bb = tid & 63;
  float wv[16];
#pragma unroll
  for (int i = 0; i < 16; i++) wv[i] = src[(size_t)(k0 + i * 4 + a) * N + n0 + bb];
#pragma unroll
  for (int i = 0; i < 16; i++) tl[(i * 4 + a) * 65 + bb] = wv[i];
  __syncthreads();
#pragma unroll 4
  for (int i = 0; i < 16; i++) {
    int n = i * 4 + a;
    dst[(size_t)(n0 + n) * K + k0 + bb] = f2bf(tl[bb * 65 + n]);
  }
  __syncthreads();
}

__device__ __forceinline__ void wconv_layer(const Params& p, int l, unsigned char* smem) {
  float* tl = (float*)smem;
  u16* winT = (u16*)(p.ws + OFF_WA);
  u16* wbrT = winT + (size_t)WINC * DM;
  u16* woutT = wbrT + (size_t)4 * DM * 256;
  u16* wupT = (u16*)(p.ws + OFF_WM);
  u16* wdnT = wupT + (size_t)DFF * DM;
  const int n0 = 1824, n1 = n0 + 256, n2 = n1 + 256, n3 = n2 + 1024, n4 = n3 + 1024;
  for (int it = blockIdx.x; it < n4; it += gridDim.x) {
    if (it < n0) wconv_tile(p.w_in + (size_t)l * DM * WINC, winT, DM, WINC, it, tl);
    else if (it < n1) {
      int j = it - n0, n = j >> 6;
      wconv_tile(p.w_branch + ((size_t)l * 4 + n) * 256 * DM, wbrT + (size_t)n * DM * 256, 256, DM, j & 63, tl);
    } else if (it < n2) wconv_tile(p.w_out + (size_t)l * DM * DM, woutT, DM, DM, it - n1, tl);
    else if (it < n3) wconv_tile(p.w_up + (size_t)l * DM * DFF, wupT, DM, DFF, it - n2, tl);
    else wconv_tile(p.w_down + (size_t)l * DFF * DM, wdnT, DFF, DM, it - n3, tl);
  }
}

__device__ __forceinline__ void phase_pro(const Params& p, unsigned char* smem) {
  const int tid = ltid(), lane = tid & 63, wid = tid >> 6;
  float* sil = (float*)smem;
  float* red = sil + 3 * DM;
  float* modv = (float*)(p.ws + OFF_MOD);
  for (int it = blockIdx.x; it < DEPTH * 96; it += gridDim.x) {
    int l = it / 96, cgp = it - l * 96;
    for (int i = tid; i < 3 * DM; i += 256) {
      int w = i >> 10, k = i & 1023;
      float v = w < 2 ? p.c[w * DM + k] : p.c_ctx[k];
      sil[i] = v * fsigmoid(v);
    }
    __syncthreads();
    const float* W = p.ada_w + (size_t)l * DM * 6 * DM + cgp * 64 + lane;
    float a0 = 0.f, a1 = 0.f, a2 = 0.f;
#pragma unroll 16
    for (int k = wid * 256; k < wid * 256 + 256; k++) {
      float w = W[(size_t)k * 6 * DM];
      a0 += sil[k] * w; a1 += sil[DM + k] * w; a2 += sil[2 * DM + k] * w;
    }
    red[(wid * 3 + 0) * 64 + lane] = a0; red[(wid * 3 + 1) * 64 + lane] = a1; red[(wid * 3 + 2) * 64 + lane] = a2;
    __syncthreads();
    if (tid < 192) {
      int w = tid >> 6;
      float s = red[(0 * 3 + w) * 64 + lane] + red[(1 * 3 + w) * 64 + lane] + red[(2 * 3 + w) * 64 + lane] + red[(3 * 3 + w) * 64 + lane];
      int col = cgp * 64 + lane;
      modv[(size_t)(l * 3 + w) * 6 * DM + col] = s + p.ada_b[(size_t)l * 6 * DM + col];
    }
    __syncthreads();
  }
  const size_t gtid = (size_t)blockIdx.x * 256 + tid, gsz = (size_t)gridDim.x * 256;
  {
    f2* tabC = (f2*)(p.ws + OFF_TAB);
    f2* tabAr = tabC + 16384 * 16; f2* tabAc = tabAr + 256 * 8; f2* tabDr = tabAc + 64 * 8; f2* tabDc = tabDr + 256 * 16;
    const int total = 16384 * 16 + 256 * 8 + 64 * 8 + 256 * 16 + 64 * 16;
    for (size_t i = gtid; i < (size_t)total; i += gsz) {
      int e = (int)i; int pos, j, nf; f2* dst;
      if (e < 16384 * 16) { pos = e >> 4; j = e & 15; nf = 16; dst = tabC + e; }
      else if ((e -= 16384 * 16) < 256 * 8) { pos = e >> 3; j = e & 7; nf = 8; dst = tabAr + e; }
      else if ((e -= 256 * 8) < 64 * 8) { pos = e >> 3; j = e & 7; nf = 8; dst = tabAc + e; }
      else if ((e -= 64 * 8) < 256 * 16) { pos = e >> 4; j = e & 15; nf = 16; dst = tabDr + e; }
      else { e -= 256 * 16; pos = e >> 4; j = e & 15; nf = 16; dst = tabDc + e; }
      double base = nf == 8 ? 0.31622776601683794 : 0.5623413251903491;
      double f = 1.0;
      for (int q = 0; q < j; q++) f *= base;
      float inv = (float)f;
      float ang = (float)pos * inv;
      double rev = (double)ang * 0.15915494309189535;
      rev -= floor(rev);
      float rv = (float)rev;
      f2 cs; cs.x = __builtin_amdgcn_cosf(rv); cs.y = __builtin_amdgcn_sinf(rv);
      *dst = cs;
    }
  }
  wconv_layer(p, 0, smem);
}

__device__ __forceinline__ void phase_rows(const Params& p, int l, int mode) {
  const int tid = ltid(), lane = tid & 63, wid = __builtin_amdgcn_readfirstlane(tid >> 6);
  u16* H = (u16*)(p.ws + OFF_H);
  const u16* src = (const u16*)(p.ws + (mode == 1 ? OFF_MO : OFF_DN));
  for (int row = blockIdx.x * 4 + wid; row < NR; row += gridDim.x * 4) {
    float* xr = xrow(p, row);
    const float* xsrc = (l == 0 && mode <= 1) ? xrow_in(p, row) : xr;
    f4 xv[4];
#pragma unroll
    for (int i = 0; i < 4; i++) xv[i] = *(const f4*)(xsrc + lane * 4 + 256 * i);
    if (mode != 0) {
      const float* md = modrow(p, l, row);
      const float* gt = md + (mode == 1 ? 2 : 5) * DM;
      const float* gpost = (mode == 1 ? p.n_post_mix : p.n_post_mlp) + (size_t)l * DM;
      float mv[4][4]; float ss = 0.f;
#pragma unroll
      for (int i = 0; i < 4; i++) {
        u2 raw = *(const u2*)(src + (size_t)row * DM + lane * 4 + 256 * i);
        mv[i][0] = lo16(raw[0]); mv[i][1] = hi16(raw[0]); mv[i][2] = lo16(raw[1]); mv[i][3] = hi16(raw[1]);
#pragma unroll
        for (int j = 0; j < 4; j++) ss += mv[i][j] * mv[i][j];
      }
      ss = wsum(ss);
      float rs = rsqrtf(ss * (1.f / DM) + 1e-6f);
#pragma unroll
      for (int i = 0; i < 4; i++) {
        f4 g4 = *(const f4*)(gpost + lane * 4 + 256 * i);
        f4 t4 = *(const f4*)(gt + lane * 4 + 256 * i);
#pragma unroll
        for (int j = 0; j < 4; j++) xv[i][j] += t4[j] * (mv[i][j] * rs * g4[j]);
        *(f4*)(xr + lane * 4 + 256 * i) = xv[i];
      }
    }
    int ln = mode == 2 ? l + 1 : l;
    if (ln < DEPTH) {
      const float* md = modrow(p, ln, row);
      const float* sh = md + (mode == 1 ? 3 : 0) * DM;
      const float* sc = md + (mode == 1 ? 4 : 1) * DM;
      const float* gpre = (mode == 1 ? p.n_pre_mlp : p.n_pre_mix) + (size_t)ln * DM;
      float ss = 0.f;
#pragma unroll
      for (int i = 0; i < 4; i++)
#pragma unroll
        for (int j = 0; j < 4; j++) ss += xv[i][j] * xv[i][j];
      ss = wsum(ss);
      float rs = rsqrtf(ss * (1.f / DM) + 1e-6f);
#pragma unroll
      for (int i = 0; i < 4; i++) {
        f4 g4 = *(const f4*)(gpre + lane * 4 + 256 * i);
        f4 s4 = *(const f4*)(sh + lane * 4 + 256 * i);
        f4 c4 = *(const f4*)(sc + lane * 4 + 256 * i);
        float o[4];
#pragma unroll
        for (int j = 0; j < 4; j++) o[j] = xv[i][j] * rs * g4[j] * (1.f + c4[j]) + s4[j];
        u2 pk; pk[0] = pk2(o[0], o[1]); pk[1] = pk2(o[2], o[3]);
        *(u2*)(H + (size_t)row * DM + lane * 4 + 256 * i) = pk;
      }
    }
  }
}

__device__ __forceinline__ void phase_gemm1(const Params& p, int l, unsigned char* smem) {
  const u16* H = (const u16*)(p.ws + OFF_H);
  const u16* winT = (const u16*)(p.ws + OFF_WA);
  u16* ACD = (u16*)(p.ws + OFF_ACD);
  u16* CB = (u16*)(p.ws + OFF_CB);
  const f2* tabC = (const f2*)(p.ws + OFF_TAB);
  const f2* tabAr = tabC + 16384 * 16; const f2* tabAc = tabAr + 256 * 8; const f2* tabDr = tabAc + 64 * 8; const f2* tabDc = tabDr + 256 * 16;
  GemmPipe<2> pp;
  int mt, nt;
  bool have = gemm_tile_of(0, 25, mt, nt);
  if (have) gemm_prefetch<2>(pp, H + (size_t)mt * 128 * DM, DM, winT + (size_t)nt * 128 * DM, DM);
  for (int kk = 0; have; kk++) {
    const int m0 = mt * 128, n0 = nt * 128;
    f16 acc[2][2];
    zero_acc<2>(acc);
    gemm_main<2>(acc, pp, H + (size_t)m0 * DM, DM, winT + (size_t)n0 * DM, DM, DM, (u16*)smem);
    const int ntc = nt;
    have = gemm_tile_of(kk + 1, 25, mt, nt);
    if (have) gemm_prefetch<2>(pp, H + (size_t)mt * 128 * DM, DM, winT + (size_t)nt * 128 * DM, DM);
    {
      const int nt = ntc;
    int cls; float scale = 1.f; u16* dst; int dpitch;
    if (nt < 4) { cls = 1; if (nt < 2) scale = 0.17677669529663687f * LOG2E; }
    else if (nt == 15 || nt == 16) { cls = 2; if (nt == 16) scale = 0.17677669529663687f; }
    else if (nt >= 21 && nt < 24) { cls = 3; if (nt < 23) scale = 0.125f * LOG2E; }
    else cls = 0;
    if (n0 < 768) { dst = ACD + n0; dpitch = PACD; }
    else if (n0 < 1920) { dst = CB + (n0 - 768); dpitch = PCB; }
    else { dst = ACD + (n0 - 1152); dpitch = PACD; }
    gemm_epi<2>(acc, (float*)smem, [&](int row, int c8, const float* e) {
      const int grow = m0 + row;
      const int b = grow >= TT ? 1 : 0;
      const int t = grow - b * TT;
      float v[8];
      if (cls == 0 || t < CTX) {
#pragma unroll
        for (int i = 0; i < 8; i++) v[i] = e[i] * scale;
      } else {
        const int n = t - CTX;
        const f2* tb; bool first; int dist;
        if (cls == 1) { int ee = c8 & 31; int half = ee >> 4; first = (ee & 15) < 8; dist = 8; tb = half ? tabAc + (n & 63) * 8 : tabAr + (n >> 6) * 8; }
        else if (cls == 2) { int ee = c8 & 31; first = ee < 16; dist = 16; tb = tabC + n * 16 + (ee & 15); }
        else { int ee = c8 & 63; int half = ee >> 5; int i0 = ee & 31; first = i0 < 16; dist = 16; tb = (half ? tabDc + (n & 63) * 16 : tabDr + (n >> 6) * 16) + (i0 & 15); }
#pragma unroll
        for (int i = 0; i < 8; i++) {
          f2 cs = tb[i];
          float pp = first ? -e[i + dist] : e[i - dist];
          v[i] = (e[i] * cs.x + pp * cs.y) * scale;
        }
      }
      store8(dst + (size_t)grow * dpitch + c8, v);
    });
    }
  }
}

__device__ __forceinline__ void prepb_tile(const Params& p, int l, int tile, float* act) {
  const int c = ltid(), lane = c & 63;
  const u16* CB = (const u16*)(p.ws + OFF_CB);
  u16* scan = (u16*)(p.ws + OFF_SCAN);
  u16* GB = (u16*)(p.ws + OFF_GB);
  const int r0 = tile * 16;
  const int b = r0 >= TT ? 1 : 0;
  const int t0 = r0 - b * TT;
  const int seg0 = t0 < CTX ? 0 : CTX, seg1 = t0 < CTX ? CTX : TT;
  const float* mu = p.mu + (size_t)l * PCB;
  const float mu0 = mu[c], mu1 = mu[256 + c], mu2 = mu[512 + c], mu3 = mu[768 + c], mu4 = c < 128 ? mu[1024 + c] : 0.f;
  const float ckk = p.rkk[l * 256 + c], cka = p.rka[l * 256 + c];
  float* kls = act + 16 * 384;
  float* kkls = kls + 16 * 256;
  u16 raw[18][5];
#pragma unroll
  for (int j = 0; j < 18; j++) {
    const int t = t0 - 1 + j;
    const bool ok = t >= seg0 && t < seg1;
    const u16* rp = CB + (size_t)(b * TT + (ok ? t : t0)) * PCB;
    raw[j][0] = rp[c]; raw[j][1] = rp[256 + c]; raw[j][2] = rp[512 + c]; raw[j][3] = rp[768 + c];
    raw[j][4] = rp[1024 + (c & 127)];
    if (!ok) { raw[j][0] = 0; raw[j][1] = 0; raw[j][2] = 0; raw[j][3] = 0; raw[j][4] = 0; }
  }
#pragma unroll
  for (int j = 0; j < 16; j++) {
    const int t = t0 + j;
    const size_t orow = (size_t)(b * TT + t) * 256;
    const float cu0 = bf2f(raw[j + 1][0]), cu1 = bf2f(raw[j + 1][1]), cu2 = bf2f(raw[j + 1][2]), cu3 = bf2f(raw[j + 1][3]), cu4 = bf2f(raw[j + 1][4]);
    const float sm0 = 0.5f * (bf2f(raw[j][0]) + bf2f(raw[j + 2][0])), sm1 = 0.5f * (bf2f(raw[j][1]) + bf2f(raw[j + 2][1]));
    const float sm2 = 0.5f * (bf2f(raw[j][2]) + bf2f(raw[j + 2][2])), sm3 = 0.5f * (bf2f(raw[j][3]) + bf2f(raw[j + 2][3]));
    const float sm4 = 0.5f * (bf2f(raw[j][4]) + bf2f(raw[j + 2][4]));
    float xr = cu0 + (sm0 - cu0) * mu0;
    float xk = cu1 + (sm1 - cu1) * mu1;
    float xv = cu2 + (sm2 - cu2) * mu2;
    float x3 = cu3 + (sm3 - cu3) * mu3;
    float x4 = cu4 + (sm4 - cu4) * mu4;
    scan[0 * ARR + orow + c] = f2bf(xr);
    scan[1 * ARR + orow + c] = f2bf(xv);
    kls[j * 256 + c] = xk;
    float kk = xk * ckk;
    float ssq = wsum(kk * kk);
    kk *= rsqrtf(fmaxf(ssq, 1e-12f));
    kkls[j * 256 + c] = kk;
    scan[2 * ARR + orow + c] = f2bf(kk);
    act[j * 384 + c] = c < 128 ? (1.f - 2.f * __builtin_amdgcn_rcpf(1.f + __expf(2.f * x3))) : x3;
    if (c < 128) act[j * 384 + 256 + c] = fsigmoid(x4);
  }
  __syncthreads();
  const size_t obase = (size_t)(b * TT + t0) * 256 + c;
  {
    auto wptr = [&](int idx) -> const float* {
      if (idx < 8) {
        const int d = idx >> 2, isa = (idx >> 1) & 1, hf = idx & 1;
        return (isa ? p.a2 : p.w2) + ((size_t)(l * 2 + d) * 64 + hf * 32) * 256 + c;
      }
      return p.g2 + ((size_t)l * 128 + (idx - 8) * 32) * 256 + c;
    };
    auto aoff = [&](int idx) -> int {
      if (idx < 8) { const int d = idx >> 2, isa = (idx >> 1) & 1, hf = idx & 1; return (isa ? 128 : 0) + d * 64 + hf * 32; }
      return 256 + (idx - 8) * 32;
    };
    float wA[32], wB[32], acc[16];
#pragma unroll
    for (int k = 0; k < 32; k++) wA[k] = wptr(0)[k * 256];
#pragma unroll
    for (int j = 0; j < 16; j++) acc[j] = 0.f;
#pragma unroll
    for (int idx = 0; idx < 12; idx++) {
      if (idx + 1 < 12) {
        const float* wp = wptr(idx + 1);
        if ((idx & 1) == 0) {
#pragma unroll
          for (int k = 0; k < 32; k++) wB[k] = wp[k * 256];
        } else {
#pragma unroll
          for (int k = 0; k < 32; k++) wA[k] = wp[k * 256];
        }
      }
      const int ao = aoff(idx);
#pragma unroll
      for (int k = 0; k < 32; k += 4) {
#pragma unroll
        for (int j = 0; j < 16; j++) {
          f4 a = *(const f4*)(act + j * 384 + ao + k);
          if ((idx & 1) == 0) acc[j] += a[0] * wA[k] + a[1] * wA[k + 1] + a[2] * wA[k + 2] + a[3] * wA[k + 3];
          else acc[j] += a[0] * wB[k] + a[1] * wB[k + 1] + a[2] * wB[k + 2] + a[3] * wB[k + 3];
        }
      }
      if (idx == 1 || idx == 5) {
        const int d = idx >> 2;
        const float w0c = p.w0[(l * 2 + d) * 256 + c];
#pragma unroll
        for (int j = 0; j < 16; j++) {
          float xx = -(w0c + acc[j]);
          float sp = fmaxf(xx, 0.f) + __logf(1.f + __expf(-fabsf(xx)));
          float wlog = -sp - 0.5f;
          float lam = __expf(wlog) * LOG2E;
          scan[(3 + 3 * d) * ARR + obase + (size_t)j * 256] = f2bf(lam);
          acc[j] = 0.f;
        }
      } else if (idx == 3 || idx == 7) {
        const int d = idx >> 2;
        const float a0c = p.a0[(l * 2 + d) * 256 + c];
#pragma unroll
        for (int j = 0; j < 16; j++) {
          float a = fsigmoid(a0c + acc[j]);
          float kd = kls[j * 256 + c] * (1.f + (a - 1.f) * cka);
          scan[(4 + 3 * d) * ARR + obase + (size_t)j * 256] = f2bf(kd);
          scan[(5 + 3 * d) * ARR + obase + (size_t)j * 256] = f2bf(kkls[j * 256 + c] * a);
          acc[j] = 0.f;
        }
      } else if (idx == 11) {
#pragma unroll
        for (int j = 0; j < 16; j++) GB[obase + (size_t)j * 256] = f2bf(acc[j]);
      }
    }
  }
  __syncthreads();
}

__device__ __forceinline__ float ret_lg(const Params& p, int l, int d, int h) {
  float x = p.ret_decay[(l * 2 + d) * 4 + h];
  return -__log2f(1.f + __expf(-x));
}
__device__ __forceinline__ void retc1_item(const Params& p, int l, int item, float* sm) {
  const int tid = ltid();
  const int h = item & 3, bb = item >> 2;
  const int b = bb / 130, blk = bb - b * 130;
  const u16* ACD = (const u16*)(p.ws + OFF_ACD);
  float* Ks = sm;
  float* Vs = sm + 128 * 32;
  float* dec = Vs + 128 * 64;
  const size_t row0 = (size_t)b * TT + blk * 128;
  const float lgf = ret_lg(p, l, 0, h), lgb = ret_lg(p, l, 1, h);
  {
    u4 kv[2], vv[4];
#pragma unroll
    for (int i = 0; i < 2; i++) { const int ch = tid + 256 * i; kv[i] = *(const u4*)(ACD + (row0 + (ch >> 2)) * PACD + 896 + h * 32 + (ch & 3) * 8); }
#pragma unroll
    for (int i = 0; i < 4; i++) { const int ch = tid + 256 * i; vv[i] = *(const u4*)(ACD + (row0 + (ch >> 3)) * PACD + 1024 + h * 64 + (ch & 7) * 8); }
#pragma unroll
    for (int i = 0; i < 2; i++) {
      const int ch = tid + 256 * i, j = ch >> 2, q8 = (ch & 3) * 8;
#pragma unroll
      for (int e = 0; e < 4; e++) { Ks[j * 32 + q8 + 2 * e] = lo16(kv[i][e]); Ks[j * 32 + q8 + 2 * e + 1] = hi16(kv[i][e]); }
    }
#pragma unroll
    for (int i = 0; i < 4; i++) {
      const int ch = tid + 256 * i, j = ch >> 3, q8 = (ch & 7) * 8;
#pragma unroll
      for (int e = 0; e < 4; e++) { Vs[j * 64 + q8 + 2 * e] = lo16(vv[i][e]); Vs[j * 64 + q8 + 2 * e + 1] = hi16(vv[i][e]); }
    }
  }
  if (tid < 128) { dec[tid] = fexp2((127 - tid) * lgf); dec[128 + tid] = fexp2(tid * lgb); }
  __syncthreads();
  const int dv = tid & 63, dkg = tid >> 6;
  float af[8], ab[8];
#pragma unroll
  for (int i = 0; i < 8; i++) { af[i] = 0.f; ab[i] = 0.f; }
  for (int j = 0; j < 128; j++) {
    float v = Vs[j * 64 + dv];
    float vf = v * dec[j], vb = v * dec[128 + j];
    f4 k0 = *(const f4*)(Ks + j * 32 + dkg * 8), k1 = *(const f4*)(Ks + j * 32 + dkg * 8 + 4);
#pragma unroll
    for (int i = 0; i < 4; i++) { af[i] += k0[i] * vf; ab[i] += k0[i] * vb; af[4 + i] += k1[i] * vf; ab[4 + i] += k1[i] * vb; }
  }
  float* dS = (float*)(p.ws + OFF_DS);
  float* of = dS + ((size_t)(((b * 4 + h) * 2 + 0) * 130 + blk)) * 2048 + dv * 32 + dkg * 8;
  float* ob = dS + ((size_t)(((b * 4 + h) * 2 + 1) * 130 + blk)) * 2048 + dv * 32 + dkg * 8;
#pragma unroll
  for (int i = 0; i < 8; i++) { of[i] = af[i]; ob[i] = ab[i]; }
  __syncthreads();
}
__device__ __forceinline__ void retc2_item(const Params& p, int l, int item) {
  const int e = item * 256 + ltid();
  const int bhd = e >> 11, el = e & 2047;
  const int d = bhd & 1, h = (bhd >> 1) & 3;
  const float cdec = fexp2(128.f * ret_lg(p, l, d, h));
  const float* dS = (const float*)(p.ws + OFF_DS) + (size_t)bhd * 130 * 2048 + el;
  u16* Sin = (u16*)(p.ws + OFF_SIN) + (size_t)bhd * 130 * 2048 + el;
  float S = 0.f;
  for (int i0 = 0; i0 < 130; i0 += 13) {
    float dv[13];
#pragma unroll
    for (int u = 0; u < 13; u++) {
      const int i = i0 + u;
      const int blk = d == 0 ? i : (i == 0 ? 1 : (i == 1 ? 0 : 131 - i));
      dv[u] = dS[(size_t)blk * 2048];
    }
#pragma unroll
    for (int u = 0; u < 13; u++) {
      const int i = i0 + u;
      const int blk = d == 0 ? i : (i == 0 ? 1 : (i == 1 ? 0 : 131 - i));
      Sin[(size_t)blk * 2048] = f2bf(S);
      S = S * cdec + dv[u];
    }
  }
}
__device__ __forceinline__ void retc3_item(const Params& p, int l, int item, u16* sm) {
  const int tid = ltid(), lane = tid & 63, w = __builtin_amdgcn_readfirstlane(tid >> 6), r = lane & 31, hh = lane >> 5;
  const int h = item & 3, bb = item >> 2;
  const int b = bb / 130, blk = bb - b * 130;
  u16* ACD = (u16*)(p.ws + OFF_ACD);
  u16* Kt = sm;
  u16* Vt = sm + 128 * 40;
  const size_t row0 = (size_t)b * TT + blk * 128;
  const float lgf = ret_lg(p, l, 0, h), lgb = ret_lg(p, l, 1, h);
  const int iq = 32 * w + r;
  const size_t qrow = row0 + iq;
  u4 kst[2], vst[2][2], qraw[2], sfr[2][2][2];
  u2 graw[2][4];
#pragma unroll
  for (int i = 0; i < 2; i++) { const int cI = tid + 256 * i; kst[i] = *(const u4*)(ACD + (row0 + (cI >> 2)) * PACD + 896 + h * 32 + (cI & 3) * 8); }
#pragma unroll
  for (int i = 0; i < 2; i++) {
    const int u = tid + 256 * i, kp = u >> 3, dg = u & 7;
    vst[i][0] = *(const u4*)(ACD + (row0 + 2 * kp) * PACD + 1024 + h * 64 + dg * 8);
    vst[i][1] = *(const u4*)(ACD + (row0 + 2 * kp + 1) * PACD + 1024 + h * 64 + dg * 8);
  }
  qraw[0] = *(const u4*)(ACD + qrow * PACD + 768 + h * 32 + 8 * hh);
  qraw[1] = *(const u4*)(ACD + qrow * PACD + 768 + h * 32 + 16 + 8 * hh);
  {
    const u16* Sin = (const u16*)(p.ws + OFF_SIN);
#pragma unroll
    for (int d = 0; d < 2; d++)
#pragma unroll
      for (int s2 = 0; s2 < 2; s2++)
#pragma unroll
        for (int dt = 0; dt < 2; dt++)
          sfr[d][s2][dt] = *(const u4*)(Sin + ((size_t)(((b * 4 + h) * 2 + d) * 130 + blk)) * 2048 + (32 * dt + r) * 32 + 16 * s2 + 8 * hh);
  }
#pragma unroll
  for (int dt = 0; dt < 2; dt++)
#pragma unroll
    for (int i4 = 0; i4 < 4; i4++) graw[dt][i4] = *(const u2*)(ACD + qrow * PACD + 1280 + h * 64 + 32 * dt + 8 * i4 + 4 * hh);
#pragma unroll
  for (int i = 0; i < 2; i++) { const int cI = tid + 256 * i; *(u4*)(Kt + (cI >> 2) * 40 + (cI & 3) * 8) = kst[i]; }
#pragma unroll
  for (int i = 0; i < 2; i++) {
    const int u = tid + 256 * i, kp = u >> 3, dg = u & 7;
#pragma unroll
    for (int e = 0; e < 4; e++) {
      unsigned a = vst[i][0][e], c2 = vst[i][1][e];
      *(unsigned*)(Vt + (dg * 8 + 2 * e) * 136 + 2 * kp) = (a & 0xffffu) | (c2 << 16);
      *(unsigned*)(Vt + (dg * 8 + 2 * e + 1) * 136 + 2 * kp) = (a >> 16) | (c2 & 0xffff0000u);
    }
  }
  __syncthreads();
  f16 oacc[2];
#pragma unroll
  for (int i = 0; i < 16; i++) { oacc[0][i] = 0.f; oacc[1][i] = 0.f; }
#pragma unroll
  for (int kb = 0; kb < 4; kb++) {
    f16 st;
#pragma unroll
    for (int i = 0; i < 16; i++) st[i] = 0.f;
#pragma unroll
    for (int s = 0; s < 2; s++) {
      bf8 a = *(const bf8*)(Kt + (32 * kb + swz23(r)) * 40 + 16 * s + 8 * hh);
      st = __builtin_amdgcn_mfma_f32_32x32x16_bf16(a, __builtin_bit_cast(bf8, qraw[s]), st, 0, 0, 0);
    }
    u4 pb[2];
#pragma unroll
    for (int i = 0; i < 16; i++) {
      int key = 32 * kb + (i & 7) + 8 * hh + 16 * (i >> 3);
      int dd = iq - key;
      float wgt = dd > 0 ? fexp2((float)dd * lgf) : (dd < 0 ? fexp2((float)(-dd) * lgb) : 2.f);
      st[i] *= wgt;
    }
#pragma unroll
    for (int s = 0; s < 2; s++)
#pragma unroll
      for (int q = 0; q < 4; q++) pb[s][q] = pk2(st[8 * s + 2 * q], st[8 * s + 2 * q + 1]);
#pragma unroll
    for (int dt = 0; dt < 2; dt++)
#pragma unroll
      for (int s = 0; s < 2; s++) {
        bf8 a = *(const bf8*)(Vt + (32 * dt + r) * 136 + 32 * kb + 16 * s + 8 * hh);
        oacc[dt] = __builtin_amdgcn_mfma_f32_32x32x16_bf16(a, __builtin_bit_cast(bf8, pb[s]), oacc[dt], 0, 0, 0);
      }
  }
  {
    const float qdf = fexp2((float)(iq + 1) * lgf), qdb = fexp2((float)(128 - iq) * lgb);
#pragma unroll
    for (int d = 0; d < 2; d++) {
      const float qd = d == 0 ? qdf : qdb;
#pragma unroll
      for (int s = 0; s < 2; s++) {
        u4 qs;
#pragma unroll
        for (int q = 0; q < 4; q++) qs[q] = pk2(lo16(qraw[s][q]) * qd, hi16(qraw[s][q]) * qd);
#pragma unroll
        for (int dt = 0; dt < 2; dt++) {
          oacc[dt] = __builtin_amdgcn_mfma_f32_32x32x16_bf16(__builtin_bit_cast(bf8, sfr[d][s][dt]), __builtin_bit_cast(bf8, qs), oacc[dt], 0, 0, 0);
        }
      }
    }
  }
  float sum = 0.f;
#pragma unroll
  for (int dt = 0; dt < 2; dt++)
#pragma unroll
    for (int i = 0; i < 16; i++) sum += oacc[dt][i];
  sum = xhalf_sum(sum);
  const float mean = sum * (1.f / 64.f);
  float var = 0.f;
#pragma unroll
  for (int dt = 0; dt < 2; dt++)
#pragma unroll
    for (int i = 0; i < 16; i++) { float dlt = oacc[dt][i] - mean; var += dlt * dlt; }
  var = xhalf_sum(var) * (1.f / 64.f);
  const float rstd = rsqrtf(var + 1e-5f);
  const float* gn = p.ret_gn + l * 256 + h * 64;
#pragma unroll
  for (int dt = 0; dt < 2; dt++)
#pragma unroll
    for (int i4 = 0; i4 < 4; i4++) {
      const int dv = 32 * dt + 8 * i4 + 4 * hh;
      u16* gp = ACD + qrow * PACD + 1280 + h * 64 + dv;
      const u2 gr = graw[dt][i4];
      float g[4] = {lo16(gr[0]), hi16(gr[0]), lo16(gr[1]), hi16(gr[1])};
      float o[4];
#pragma unroll
      for (int q = 0; q < 4; q++) {
        float y = (oacc[dt][4 * i4 + q] - mean) * rstd * gn[dv + q];
        o[q] = y * g[q] * fsigmoid(g[q]);
      }
      u2 ov; ov[0] = pk2(o[0], o[1]); ov[1] = pk2(o[2], o[3]);
      *(u2*)gp = ov;
    }
  __syncthreads();
}

constexpr int SLOT = 64 * LDT;
constexpr int MABS = 68;
__device__ __forceinline__ int rw_row(int d, int b, int i) {
  int t = d == 0 ? i : (i < CTX ? CTX - 1 - i : TT + CTX - 1 - i);
  return b * TT + t;
}
template <bool PERM>
__device__ __forceinline__ void mm64(f16& acc, const u16* A, const u16* B, int tm, int tn, int r, int hh) {
  const int ar = PERM ? swz23(r) : r;
#pragma unroll
  for (int s = 0; s < 4; s++) {
    bf8 a = *(const bf8*)(A + (32 * tm + ar) * LDT + 16 * s + 8 * hh);
    bf8 bb = *(const bf8*)(B + (32 * tn + r) * LDT + 16 * s + 8 * hh);
    acc = __builtin_amdgcn_mfma_f32_32x32x16_bf16(a, bb, acc, 0, 0, 0);
  }
}
__device__ __forceinline__ void zero16(f16& a) {
#pragma unroll
  for (int i = 0; i < 16; i++) a[i] = 0.f;
}
template <int MASK>
__device__ __forceinline__ void put_tile(u16* dst, const f16& acc, int tm, int tn, int r, int hh) {
#pragma unroll
  for (int i = 0; i < 16; i++) {
    int row = 32 * tm + (i & 3) + 8 * (i >> 2) + 4 * hh, col = 32 * tn + r;
    float v = acc[i];
    if (MASK == 1 && !(row > col)) v = 0.f;
    if (MASK == 2 && !(row >= col)) v = 0.f;
    dst[row * LDT + col] = f2bf(v);
  }
}
template <int MASK>
__device__ __forceinline__ void put_tile_T(u16* dst, const f16& acc, int tm, int tn, int r, int hh) {
#pragma unroll
  for (int i4 = 0; i4 < 4; i4++) {
    const int row0 = 32 * tm + 8 * i4 + 4 * hh, col = 32 * tn + r;
    float v[4];
#pragma unroll
    for (int q = 0; q < 4; q++) {
      v[q] = acc[4 * i4 + q];
      if (MASK == 3 && !(((row0 + q) >> 4) > (col >> 4))) v[q] = 0.f;
    }
    u2 o; o[0] = pk2(v[0], v[1]); o[1] = pk2(v[2], v[3]);
    *(u2*)(dst + col * LDT + row0) = o;
  }
}

template <int MODE>
__device__ __forceinline__ void rwkv_chunk(const Params& p, int b, int h, int d, int c, u16* sm, f16& yout) {
  const int tid = ltid(), lane = tid & 63, w = __builtin_amdgcn_readfirstlane(tid >> 6), r = lane & 31, hh = lane >> 5;
  const int tm = w >> 1, tn = w & 1;
  u16 *x0 = sm, *x1 = sm + SLOT, *x2 = sm + 2 * SLOT, *x3 = sm + 3 * SLOT, *x4 = sm + 4 * SLOT, *x5 = sm + 5 * SLOT,
      *x6 = sm + 6 * SLOT, *x7 = sm + 7 * SLOT;
  float* dg = (float*)(sm + 8 * SLOT);
  float* qs = dg + 1024;
  float* wc = qs + 256;
  u16* AHT = MODE == 0 ? x6 : x5;
  u16* LTN = MODE == 0 ? x7 : x6;
  u16* TD = MODE == 0 ? x2 : x1;
  const u16* scan = (const u16*)(p.ws + OFF_SCAN);
  unsigned char* cbase = p.ws + OFF_CB + ((size_t)(((b * 4 + h) * 2 + d) * 260 + c)) * 16384;
  {
    const int k = lane, q = w, col = h * 64 + k;
    float lam[16], run = 0.f;
#pragma unroll
    for (int u = 0; u < 16; u++) {
      size_t ro = (size_t)rw_row(d, b, 64 * c + 16 * q + u) * 256 + col;
      lam[u] = bf2f(scan[(size_t)(3 + 3 * d) * ARR + ro]);
      run += lam[u];
    }
    u16 rkk[16], rbb[16], rkd[16], rvv[16], rrr[16];
#pragma unroll
    for (int u = 0; u < 16; u++) {
      size_t ro = (size_t)rw_row(d, b, 64 * c + 16 * q + u) * 256 + col;
      rkk[u] = scan[2 * ARR + ro];
      rbb[u] = scan[(size_t)(5 + 3 * d) * ARR + ro];
      rkd[u] = scan[(size_t)(4 + 3 * d) * ARR + ro];
      rvv[u] = scan[1 * ARR + ro];
      rrr[u] = MODE == 1 ? scan[0 * ARR + ro] : (u16)0;
    }
    qs[q * 64 + k] = run;
    __syncthreads();
    float pre = 0.f, tot = 0.f;
#pragma unroll
    for (int qq = 0; qq < 4; qq++) { float x = qs[qq * 64 + k]; tot += x; if (qq < q) pre += x; }
    float L = pre;
#pragma unroll
    for (int u = 0; u < 16; u++) {
      const int tau = 16 * q + u;
      const float Lp = L;
      L += lam[u];
      const float kk = bf2f(rkk[u]), bb = bf2f(rbb[u]);
      const float kd = bf2f(rkd[u]);
      const u16 vraw = rvv[u];
      const float eL = fexp2(L);
      const u16 ah = f2bf(kk * fexp2(-Lp));
      x0[tau * LDT + k] = ah;
      AHT[k * LDT + tau] = ah;
      x1[tau * LDT + k] = f2bf(bb * eL);
      x2[tau * LDT + k] = f2bf(kd * eL);
      x3[k * LDT + tau] = vraw;
      if (MODE == 0) {
        const float eC = fexp2(L - tot);
        x4[k * LDT + tau] = f2bf(bb * eC);
        x5[k * LDT + tau] = f2bf(kd * eC);
      } else {
        const float rr = bf2f(rrr[u]);
        x4[tau * LDT + k] = f2bf(rr * fexp2(-L));
      }
    }
    if (MODE == 0 && q == 0) wc[k] = fexp2(-tot);
    __syncthreads();
  }
  {
    f16 a_ab, a_ak, a_rb, a_rk;
    zero16(a_ab); zero16(a_ak); zero16(a_rb); zero16(a_rk);
    mm64<false>(a_ab, x0, x1, tm, tn, r, hh);
    mm64<false>(a_ak, x0, x2, tm, tn, r, hh);
    if (MODE == 1) {
      mm64<false>(a_rb, x4, x1, tm, tn, r, hh);
      mm64<false>(a_rk, x4, x2, tm, tn, r, hh);
    }
    __syncthreads();
#pragma unroll
    for (int i = 0; i < 16; i++) {
      int row = 32 * tm + (i & 3) + 8 * (i >> 2) + 4 * hh, col = 32 * tn + r;
      if ((row >> 4) == (col >> 4)) dg[(row >> 4) * 256 + (row & 15) * 16 + (col & 15)] = row > col ? a_ab[i] : 0.f;
    }
    put_tile_T<3>(LTN, a_ab, tm, tn, r, hh);
    put_tile<1>(x1, a_ak, tm, tn, r, hh);
    if (MODE == 1) { put_tile<2>(x2, a_rb, tm, tn, r, hh); put_tile<2>(x7, a_rk, tm, tn, r, hh); }
    __syncthreads();
  }
  {
    f16 a;
    zero16(a);
    mm64<false>(a, x1, x3, tm, tn, r, hh);
    float X[16];
    const int cc = lane & 15, gq = lane >> 4;
#pragma unroll
    for (int t = 0; t < 16; t++) {
      float acc = t == cc ? 1.f : 0.f;
#pragma unroll
      for (int j = 0; j < t; j++) acc -= dg[w * 256 + t * 16 + j] * X[j];
      X[t] = acc;
    }
    __syncthreads();
    put_tile_T<0>(x0, a, tm, tn, r, hh);
#pragma unroll
    for (int t = 0; t < 16; t++) TD[(16 * w + t) * LDT + 16 * gq + cc] = f2bf(gq == w ? X[t] : 0.f);
    __syncthreads();
  }
  {
    f16 n;
    zero16(n);
    mm64<false>(n, TD, LTN, tm, tn, r, hh);
    __syncthreads();
    put_tile<0>(LTN, n, tm, tn, r, hh);
    __syncthreads();
  }
  {
    f16 z0p, z0q;
    zero16(z0p); zero16(z0q);
    mm64<false>(z0p, TD, AHT, tm, tn, r, hh);
    mm64<false>(z0q, TD, x0, tm, tn, r, hh);
    __syncthreads();
    put_tile_T<0>(AHT, z0p, tm, tn, r, hh);
    put_tile_T<0>(x0, z0q, tm, tn, r, hh);
    __syncthreads();
#pragma unroll 1
    for (int itn = 0; itn < 3; itn++) {
      f16 np_, nq_;
      zero16(np_); zero16(nq_);
      mm64<false>(np_, LTN, AHT, tm, tn, r, hh);
      mm64<false>(nq_, LTN, x0, tm, tn, r, hh);
#pragma unroll
      for (int i = 0; i < 16; i++) { np_[i] = z0p[i] - np_[i]; nq_[i] = z0q[i] - nq_[i]; }
      __syncthreads();
      put_tile_T<0>(AHT, np_, tm, tn, r, hh);
      put_tile_T<0>(x0, nq_, tm, tn, r, hh);
      __syncthreads();
    }
  }
  if (MODE == 0) {
    f16 g;
    zero16(g);
    mm64<false>(g, x4, AHT, tm, tn, r, hh);
    u16* GT = (u16*)cbase;
#pragma unroll
    for (int i = 0; i < 16; i++) {
      int row = 32 * tm + (i & 3) + 8 * (i >> 2) + 4 * hh, col = 32 * tn + r;
      float v = (row == col ? wc[row] : 0.f) - g[i];
      GT[row * 64 + col] = f2bf(v);
    }
    f16 h1, h2;
    zero16(h1); zero16(h2);
    mm64<true>(h1, x5, x3, tm, tn, r, hh);
    mm64<true>(h2, x4, x0, tm, tn, r, hh);
    unsigned* HM = (unsigned*)(cbase + 8192) + (tm * 2 + tn) * 512;
#pragma unroll
    for (int q = 0; q < 8; q++) HM[q * 64 + lane] = pk2(h1[2 * q] - h2[2 * q], h1[2 * q + 1] - h2[2 * q + 1]);
    __syncthreads();
  } else {
    f16 ry, y1, y2;
    zero16(ry); zero16(y1); zero16(y2);
    mm64<false>(ry, x2, AHT, tm, tn, r, hh);
    mm64<false>(y1, x7, x3, tm, tn, r, hh);
    mm64<false>(y2, x2, x0, tm, tn, r, hh);
#pragma unroll
    for (int i = 0; i < 16; i++) {
      int row = 32 * tm + (i & 3) + 8 * (i >> 2) + 4 * hh, col = 32 * tn + r;
      x4[row * LDT + col] = f2bf(bf2f(x4[row * LDT + col]) - ry[i]);
      y1[i] -= y2[i];
    }
    __syncthreads();
    const unsigned char* S0 = cbase + 8192;
#pragma unroll
    for (int s = 0; s < 4; s++) {
      bf8 a = *(const bf8*)(x4 + (32 * tm + r) * LDT + 16 * s + 8 * hh);
      u4 bq = *(const u4*)(S0 + ((s >> 1) * 2 + tn) * 2048 + (s & 1) * 1024 + lane * 16);
      y1 = __builtin_amdgcn_mfma_f32_32x32x16_bf16(a, __builtin_bit_cast(bf8, bq), y1, 0, 0, 0);
    }
    yout = y1;
    __syncthreads();
  }
}

__device__ __forceinline__ void rwkv_s1_item(const Params& p, int item, u16* sm) {
  const int c = item % 260, chain = item / 260;
  f16 dummy;
  rwkv_chunk<0>(p, chain >> 3, (chain >> 1) & 3, chain & 1, c, sm, dummy);
}

__device__ __forceinline__ void rwkv_s2_item(const Params& p, int item) {
  const int tid = ltid(), lane = tid & 63, w = __builtin_amdgcn_readfirstlane(tid >> 6), r = lane & 31, hh = lane >> 5;
  const int chain = item * 2 + (w >> 1), vt = w & 1;
  unsigned char* base = p.ws + OFF_CB + (size_t)chain * 260 * 16384;
  f16 acc[2];
  zero16(acc[0]); zero16(acc[1]);
  u4 g[2][4]; unsigned hm[2][8];
  const int goff = (swz23(r) * 64 + 8 * hh) * 2;
#pragma unroll
  for (int kt = 0; kt < 2; kt++) {
#pragma unroll
    for (int s = 0; s < 4; s++) g[kt][s] = *(const u4*)(base + goff + kt * 32 * 128 + s * 32);
#pragma unroll
    for (int q = 0; q < 8; q++) hm[kt][q] = *(const unsigned*)(base + 8192 + (((kt * 2 + vt) * 8 + q) * 64 + lane) * 4);
  }
  for (int c = 0; c < 260; c++) {
    u4 gn[2][4]; unsigned hn[2][8];
    unsigned char* cb = base + (size_t)c * 16384;
    {
      const unsigned char* nb = base + (size_t)(c + 1 < 260 ? c + 1 : c) * 16384;
#pragma unroll
      for (int kt = 0; kt < 2; kt++) {
#pragma unroll
        for (int s = 0; s < 4; s++) gn[kt][s] = *(const u4*)(nb + goff + kt * 32 * 128 + s * 32);
#pragma unroll
        for (int q = 0; q < 8; q++) hn[kt][q] = *(const unsigned*)(nb + 8192 + (((kt * 2 + vt) * 8 + q) * 64 + lane) * 4);
      }
    }
    u4 bfg[4];
#pragma unroll
    for (int kt = 0; kt < 2; kt++)
#pragma unroll
      for (int s2 = 0; s2 < 2; s2++)
#pragma unroll
        for (int q = 0; q < 4; q++) bfg[2 * kt + s2][q] = pk2(acc[kt][8 * s2 + 2 * q], acc[kt][8 * s2 + 2 * q + 1]);
#pragma unroll
    for (int s = 0; s < 4; s++) *(u4*)(cb + 8192 + ((s >> 1) * 2 + vt) * 2048 + (s & 1) * 1024 + lane * 16) = bfg[s];
#pragma unroll
    for (int kt = 0; kt < 2; kt++) {
      f16 a;
#pragma unroll
      for (int q = 0; q < 8; q++) { a[2 * q] = lo16(hm[kt][q]); a[2 * q + 1] = hi16(hm[kt][q]); }
#pragma unroll
      for (int s = 0; s < 4; s++)
        a = __builtin_amdgcn_mfma_f32_32x32x16_bf16(__builtin_bit_cast(bf8, g[kt][s]), __builtin_bit_cast(bf8, bfg[s]), a, 0, 0, 0);
      acc[kt] = a;
    }
#pragma unroll
    for (int kt = 0; kt < 2; kt++) {
#pragma unroll
      for (int s = 0; s < 4; s++) g[kt][s] = gn[kt][s];
#pragma unroll
      for (int q = 0; q < 8; q++) hm[kt][q] = hn[kt][q];
    }
  }
}

__device__ __forceinline__ float qsum(float x) {
  x += __builtin_bit_cast(float, __builtin_amdgcn_update_dpp(0, __builtin_bit_cast(int, x), 0xB1, 0xF, 0xF, true));
  x += __builtin_bit_cast(float, __builtin_amdgcn_update_dpp(0, __builtin_bit_cast(int, x), 0x4E, 0xF, 0xF, true));
  return x;
}
__device__ __forceinline__ void rwkv_s3_item(const Params& p, int l, int item, u16* sm) {
  const int tid = ltid(), lane = tid & 63, w = __builtin_amdgcn_readfirstlane(tid >> 6), r = lane & 31, hh = lane >> 5;
  const int tm = w >> 1, tn = w & 1;
  const int tc = item % 260, bh = item / 260, b = bh >> 2, h = bh & 3;
  f16 yf, yb;
  zero16(yf); zero16(yb);
  for (int d = 0; d < 2; d++) {
    const int c = d == 0 ? tc : (tc < 4 ? 3 - tc : 263 - tc);
    f16 y;
    rwkv_chunk<1>(p, b, h, d, c, sm, y);
    if (d == 0) yf = y; else yb = y;
  }
  float* Ys = (float*)sm;
#pragma unroll
  for (int i = 0; i < 16; i++) {
    int row = 32 * tm + (i & 3) + 8 * (i >> 2) + 4 * hh;
    Ys[row * MABS + 32 * tn + r] = yf[i];
  }
  __syncthreads();
#pragma unroll
  for (int i = 0; i < 16; i++) {
    int row = 63 - (32 * tm + (i & 3) + 8 * (i >> 2) + 4 * hh);
    Ys[row * MABS + 32 * tn + r] += yb[i];
  }
  __syncthreads();
  {
    const int tok = tid >> 2, q4 = tid & 3;
    const size_t ro = (size_t)(b * TT + 64 * tc + tok) * 256 + h * 64 + 16 * q4;
    const u16* scan = (const u16*)(p.ws + OFF_SCAN);
    u16* GB = (u16*)(p.ws + OFF_GB);
    float y[16], sum = 0.f, sq = 0.f;
#pragma unroll
    for (int i = 0; i < 4; i++) {
      f4 v4 = *(const f4*)(Ys + tok * MABS + 16 * q4 + 4 * i);
#pragma unroll
      for (int j = 0; j < 4; j++) { y[4 * i + j] = v4[j]; sum += v4[j]; sq += v4[j] * v4[j]; }
    }
    sum = qsum(sum); sq = qsum(sq);
    const float mean = sum * (1.f / 64.f);
    const float var = fmaxf(sq * (1.f / 64.f) - mean * mean, 0.f);
    const float rstd = rsqrtf(var + 64e-5f);
    float rr[16], kf[16], kb[16], vv[16], gg[16];
    auto ld16 = [&](const u16* src, float* dst) {
      u4 a = *(const u4*)src, c2 = *(const u4*)(src + 8);
#pragma unroll
      for (int e = 0; e < 4; e++) { dst[2 * e] = lo16(a[e]); dst[2 * e + 1] = hi16(a[e]); dst[8 + 2 * e] = lo16(c2[e]); dst[8 + 2 * e + 1] = hi16(c2[e]); }
    };
    ld16(scan + 0 * ARR + ro, rr); ld16(scan + 4 * ARR + ro, kf); ld16(scan + 7 * ARR + ro, kb);
    ld16(scan + 1 * ARR + ro, vv); ld16(GB + ro, gg);
    const float* rk = p.rrk + l * 256 + h * 64 + 16 * q4;
    const float* lg = p.lnx_g + l * 256 + h * 64 + 16 * q4;
    const float* lb = p.lnx_b + l * 256 + h * 64 + 16 * q4;
    float bonus = 0.f;
#pragma unroll
    for (int i = 0; i < 16; i++) bonus += rr[i] * (kf[i] + kb[i]) * rk[i];
    bonus = qsum(bonus);
    float o[16];
#pragma unroll
    for (int i = 0; i < 16; i++) o[i] = ((y[i] - mean) * rstd * lg[i] + lb[i] + bonus * vv[i]) * gg[i];
    store8(GB + ro, o);
    store8(GB + ro + 8, o + 8);
  }
  __syncthreads();
}

template <int MODE>
__device__ __forceinline__ void attn_item(const Params& p, int l, int item, u16* sm) {
  constexpr int NS = MODE == 0 ? 2 : 4;
  const int tid = ltid(), lane = tid & 63, w = __builtin_amdgcn_readfirstlane(tid >> 6), r = lane & 31, hh = lane >> 5;
  const int pl = w >> 1, rb = w & 1;
  u16* ACD = (u16*)(p.ws + OFF_ACD);
  int b, hd, qrow0, ntile, jlo = 0, qb = 0;
  bool latent;
  if (MODE == 0) {
    if (item < 2048) { b = item >> 10; hd = (item >> 8) & 3; qb = item & 255; qrow0 = b * TT + CTX + 64 * qb; ntile = 260; latent = true; }
    else { int j = item - 2048; b = j >> 4; hd = (j >> 2) & 3; qrow0 = b * TT + 64 * (j & 3); ntile = 4; latent = false; }
  } else {
    if (item < 1024) {
      b = item >> 9; hd = (item >> 8) & 1; qb = item & 255; qrow0 = b * TT + CTX + 64 * qb; latent = true;
      jlo = qb - 2; if (jlo < 0) jlo = 0;
      int jhi = qb + 3; if (jhi > 256) jhi = 256;
      ntile = 4 + (jhi - jlo);
    } else { int j = item - 1024; b = j >> 3; hd = (j >> 2) & 1; qrow0 = b * TT + 64 * (j & 3); ntile = 4; latent = false; }
  }
  const int kcol = MODE == 0 ? 256 + hd * 64 : 1792 + hd * 64;
  const int vcol = MODE == 0 ? 512 + hd * 64 : 1920 + hd * 64;
  const int qcol = MODE == 0 ? hd * 64 + 32 * pl : 1536 + hd * 128 + 64 * pl;
  const int koff = MODE == 0 ? 32 * pl : 0;
  const size_t qrow = (size_t)qrow0 + 32 * rb + r;
  bf8 qf[NS];
#pragma unroll
  for (int s = 0; s < NS; s++) qf[s] = *(const bf8*)(ACD + qrow * PACD + qcol + 16 * s + 8 * hh);
  f16 O[2], negm, lacc;
  float m = 0.f;
#pragma unroll
  for (int i = 0; i < 16; i++) { O[0][i] = 0.f; O[1][i] = 0.f; negm[i] = 0.f; lacc[i] = 0.f; }
  u4 ones_u; ones_u[0] = ones_u[1] = ones_u[2] = ones_u[3] = 0x3F803F80u;
  const bf8 ones = __builtin_bit_cast(bf8, ones_u);
  auto keyrow0 = [&](int kt) -> size_t {
    if (MODE == 0 || kt < 4) return (size_t)b * TT + 64 * kt;
    return (size_t)b * TT + CTX + 64 * (jlo + kt - 4);
  };
  u4 rkA[2], rvA[2], rkB[2], rvB[2];
  const int kr = tid >> 3, kc = (tid & 7) * 8;
  const int kp = tid >> 3, dg = tid & 7;
  auto gload = [&](u4 (&rk)[2], u4 (&rv)[2], int kt) {
    const size_t k0 = keyrow0(kt);
    rk[0] = *(const u4*)(ACD + (k0 + kr) * PACD + kcol + kc);
    rk[1] = *(const u4*)(ACD + (k0 + kr + 32) * PACD + kcol + kc);
    rv[0] = *(const u4*)(ACD + (k0 + 2 * kp) * PACD + vcol + dg * 8);
    rv[1] = *(const u4*)(ACD + (k0 + 2 * kp + 1) * PACD + vcol + dg * 8);
  };
  auto swrite = [&](const u4 (&rk)[2], const u4 (&rv)[2], int buf) {
    u16* Kb = sm + buf * 2 * 64 * LDT;
    u16* Vb = Kb + 64 * LDT;
    *(u4*)(Kb + kr * LDT + kc) = rk[0];
    *(u4*)(Kb + (kr + 32) * LDT + kc) = rk[1];
#pragma unroll
    for (int e = 0; e < 4; e++) {
      unsigned a = rv[0][e], c2 = rv[1][e];
      *(unsigned*)(Vb + (dg * 8 + 2 * e) * LDT + 2 * kp) = (a & 0xffffu) | (c2 << 16);
      *(unsigned*)(Vb + (dg * 8 + 2 * e + 1) * LDT + 2 * kp) = (a >> 16) | (c2 & 0xffff0000u);
    }
  };
  gload(rkA, rvA, 0);
  gload(rkB, rvB, 1);
  swrite(rkA, rvA, 0);
  __syncthreads();
  const int qlo = 64 * qb + 32 * rb;
  const int qpos = qlo + r;
  auto tile_body = [&](int kt, u4 (&rkL)[2], u4 (&rvL)[2], u4 (&rkW)[2], u4 (&rvW)[2]) {
    if (kt + 2 < ntile) gload(rkL, rvL, kt + 2);
    const u16* Kb = sm + (kt & 1) * 2 * 64 * LDT;
    const u16* Vb = Kb + 64 * LDT;
    bool skip = false;
    int kpos0 = 0;
    const bool masked = (MODE == 1) && latent && kt >= 4;
    if (masked) {
      kpos0 = 64 * (jlo + kt - 4);
      if (kpos0 > qlo + 31 + 128 || kpos0 + 63 < qlo - 128) skip = true;
    }
    if (!skip) {
      u4 pb[2][2];
      f16 st[2];
#pragma unroll
      for (int kb = 0; kb < 2; kb++) {
        st[kb] = negm;
#pragma unroll
        for (int s = 0; s < NS; s++) {
          bf8 a = *(const bf8*)(Kb + (32 * kb + swz23(r)) * LDT + koff + 16 * s + 8 * hh);
          st[kb] = __builtin_amdgcn_mfma_f32_32x32x16_bf16(a, qf[s], st[kb], 0, 0, 0);
        }
      }
      if (masked) {
#pragma unroll
        for (int kb = 0; kb < 2; kb++)
#pragma unroll
          for (int i = 0; i < 16; i++) {
            int kpos = kpos0 + 32 * kb + (i & 7) + 8 * hh + 16 * (i >> 3);
            int dd = qpos - kpos;
            if (dd > 128 || dd < -128) st[kb][i] = -1e30f;
          }
      }
      float mt = st[0][0];
#pragma unroll
      for (int i = 1; i < 16; i++) mt = fmaxf(mt, st[0][i]);
#pragma unroll
      for (int i = 0; i < 16; i++) mt = fmaxf(mt, st[1][i]);
      mt = xhalf_max(mt);
      const bool first = kt == 0;
      if (first || __any(mt > 8.f)) {
        const float dm = first ? mt : fmaxf(mt, 0.f);
        const float al = first ? 1.f : fexp2(-dm);
        m += dm;
        lacc[0] *= al;
#pragma unroll
        for (int i = 0; i < 16; i++) { O[0][i] *= al; O[1][i] *= al; st[0][i] -= dm; st[1][i] -= dm; negm[i] = -m; }
      }
#pragma unroll
      for (int kb = 0; kb < 2; kb++) {
#pragma unroll
        for (int i = 0; i < 16; i++) st[kb][i] = fexp2(st[kb][i]);
#pragma unroll
        for (int s = 0; s < 2; s++)
#pragma unroll
          for (int q = 0; q < 4; q++) pb[kb][s][q] = pk2(st[kb][8 * s + 2 * q], st[kb][8 * s + 2 * q + 1]);
      }
#pragma unroll
      for (int kb = 0; kb < 2; kb++)
#pragma unroll
        for (int s = 0; s < 2; s++)
          lacc = __builtin_amdgcn_mfma_f32_32x32x16_bf16(ones, __builtin_bit_cast(bf8, pb[kb][s]), lacc, 0, 0, 0);
#pragma unroll
      for (int dt = 0; dt < 2; dt++)
#pragma unroll
        for (int kb = 0; kb < 2; kb++)
#pragma unroll
          for (int s = 0; s < 2; s++) {
            bf8 a = *(const bf8*)(Vb + (32 * dt + r) * LDT + 32 * kb + 16 * s + 8 * hh);
            O[dt] = __builtin_amdgcn_mfma_f32_32x32x16_bf16(a, __builtin_bit_cast(bf8, pb[kb][s]), O[dt], 0, 0, 0);
          }
    }
    if (kt + 1 < ntile) swrite(rkW, rvW, (kt + 1) & 1);
    __syncthreads();
  };
  for (int kt = 0; kt < ntile; kt += 2) {
    tile_body(kt, rkA, rvA, rkB, rvB);
    if (kt + 1 < ntile) tile_body(kt + 1, rkB, rvB, rkA, rvA);
  }
  if (MODE == 0) {
    const float lam_init = 0.8f - 0.6f * __expf(-0.3f * (float)l);
    float d0 = 0.f, d1 = 0.f;
    for (int i = 0; i < 32; i++) {
      d0 += p.lam_q[(l * 2 + 0) * 32 + i] * p.lam_k[(l * 2 + 0) * 32 + i];
      d1 += p.lam_q[(l * 2 + 1) * 32 + i] * p.lam_k[(l * 2 + 1) * 32 + i];
    }
    const float lam = __expf(d0) - __expf(d1) + lam_init;
    const float inv = (pl == 0 ? 1.f : lam) / lacc[0];
    float* xch = (float*)sm + rb * (32 * 64);
    if (pl == 1) {
#pragma unroll
      for (int dt = 0; dt < 2; dt++)
#pragma unroll
        for (int i = 0; i < 16; i++) xch[(dt * 16 + i) * 64 + lane] = O[dt][i] * inv;
    }
    __syncthreads();
    if (pl == 0) {
      float ss = 0.f;
#pragma unroll
      for (int dt = 0; dt < 2; dt++)
#pragma unroll
        for (int i = 0; i < 16; i++) { float o = O[dt][i] * inv - xch[(dt * 16 + i) * 64 + lane]; O[dt][i] = o; ss += o * o; }
      ss = xhalf_sum(ss);
      const float rs = rsqrtf(ss * (1.f / 64.f) + 1e-5f) * (1.f - lam_init);
      const float* gs = p.subln + l * 256 + hd * 64;
#pragma unroll
      for (int dt = 0; dt < 2; dt++)
#pragma unroll
        for (int i4 = 0; i4 < 4; i4++) {
          const int dv = 32 * dt + 8 * i4 + 4 * hh;
          u2 ov;
          ov[0] = pk2(O[dt][4 * i4 + 0] * rs * gs[dv + 0], O[dt][4 * i4 + 1] * rs * gs[dv + 1]);
          ov[1] = pk2(O[dt][4 * i4 + 2] * rs * gs[dv + 2], O[dt][4 * i4 + 3] * rs * gs[dv + 3]);
          *(u2*)(ACD + qrow * PACD + hd * 64 + dv) = ov;
        }
    }
    __syncthreads();
  } else {
    const float sk = p.win_sink[l * 4 + hd * 2 + pl] * LOG2E;
    const float lt = lacc[0] + fexp2(sk - m);
    const float inv = 1.f / lt;
#pragma unroll
    for (int dt = 0; dt < 2; dt++)
#pragma unroll
      for (int i4 = 0; i4 < 4; i4++) {
        const int dv = 32 * dt + 8 * i4 + 4 * hh;
        u2 ov;
        ov[0] = pk2(O[dt][4 * i4 + 0] * inv, O[dt][4 * i4 + 1] * inv);
        ov[1] = pk2(O[dt][4 * i4 + 2] * inv, O[dt][4 * i4 + 3] * inv);
        *(u2*)(ACD + qrow * PACD + 1536 + (hd * 2 + pl) * 64 + dv) = ov;
      }
  }
}

__device__ __forceinline__ void attnA2_item(const Params& p, int l, int item, u16* sm) {
  const int tid = ltid(), lane = tid & 63, w = __builtin_amdgcn_readfirstlane(tid >> 6), r = lane & 31, hh = lane >> 5;
  u16* ACD = (u16*)(p.ws + OFF_ACD);
  int b, hd, qrow0, ntile;
  if (item < 1024) { b = item >> 9; hd = (item >> 7) & 3; qrow0 = b * TT + CTX + 128 * (item & 127); ntile = 260; }
  else { int j = item - 1024; b = j >> 3; hd = (j >> 1) & 3; qrow0 = b * TT + 128 * (j & 1); ntile = 4; }
  const int kcol = 256 + hd * 64, vcol = 512 + hd * 64;
  const size_t qrow = (size_t)qrow0 + 32 * w + r;
  bf8 qf[2][2];
#pragma unroll
  for (int pl = 0; pl < 2; pl++)
#pragma unroll
    for (int s = 0; s < 2; s++) qf[pl][s] = *(const bf8*)(ACD + qrow * PACD + hd * 64 + 32 * pl + 16 * s + 8 * hh);
  f16 O[2][2];
  float m[2] = {0.f, 0.f}, lsum[2] = {0.f, 0.f};
#pragma unroll
  for (int pl = 0; pl < 2; pl++)
#pragma unroll
    for (int dt = 0; dt < 2; dt++)
#pragma unroll
      for (int i = 0; i < 16; i++) O[pl][dt][i] = 0.f;
  u4 rkA[2], rvA[2], rkB[2], rvB[2];
  const int kr = tid >> 3, kc = (tid & 7) * 8;
  const int kp = tid >> 3, dg = tid & 7;
  auto gload = [&](u4 (&rk)[2], u4 (&rv)[2], int kt) {
    const size_t k0 = (size_t)b * TT + 64 * kt;
    rk[0] = *(const u4*)(ACD + (k0 + kr) * PACD + kcol + kc);
    rk[1] = *(const u4*)(ACD + (k0 + kr + 32) * PACD + kcol + kc);
    rv[0] = *(const u4*)(ACD + (k0 + 2 * kp) * PACD + vcol + dg * 8);
    rv[1] = *(const u4*)(ACD + (k0 + 2 * kp + 1) * PACD + vcol + dg * 8);
  };
  auto swrite = [&](const u4 (&rk)[2], const u4 (&rv)[2], int buf) {
    u16* Kb = sm + buf * 2 * 64 * LDT;
    u16* Vb = Kb + 64 * LDT;
    *(u4*)(Kb + kr * LDT + kc) = rk[0];
    *(u4*)(Kb + (kr + 32) * LDT + kc) = rk[1];
#pragma unroll
    for (int e = 0; e < 4; e++) {
      unsigned a = rv[0][e], c2 = rv[1][e];
      *(unsigned*)(Vb + (dg * 8 + 2 * e) * LDT + 2 * kp) = (a & 0xffffu) | (c2 << 16);
      *(unsigned*)(Vb + (dg * 8 + 2 * e + 1) * LDT + 2 * kp) = (a >> 16) | (c2 & 0xffff0000u);
    }
  };
  gload(rkA, rvA, 0);
  gload(rkB, rvB, 1);
  swrite(rkA, rvA, 0);
  __syncthreads();
  auto tile_body = [&](int kt, u4 (&rkL)[2], u4 (&rvL)[2], u4 (&rkW)[2], u4 (&rvW)[2]) {
    if (kt + 2 < ntile) gload(rkL, rvL, kt + 2);
    const u16* Kb = sm + (kt & 1) * 2 * 64 * LDT;
    const u16* Vb = Kb + 64 * LDT;
    const bool first = kt == 0;
#pragma unroll
    for (int pl = 0; pl < 2; pl++) {
      u4 pb[2][2];
      f16 st[2];
#pragma unroll
      for (int kb = 0; kb < 2; kb++) {
#pragma unroll
        for (int i = 0; i < 16; i++) st[kb][i] = 0.f;
#pragma unroll
        for (int s = 0; s < 2; s++) {
          bf8 a = *(const bf8*)(Kb + (32 * kb + swz23(r)) * LDT + 32 * pl + 16 * s + 8 * hh);
          st[kb] = __builtin_amdgcn_mfma_f32_32x32x16_bf16(a, qf[pl][s], st[kb], 0, 0, 0);
        }
      }
      float mt = st[0][0];
#pragma unroll
      for (int i = 1; i < 16; i++) mt = fmaxf(mt, st[0][i]);
#pragma unroll
      for (int i = 0; i < 16; i++) mt = fmaxf(mt, st[1][i]);
      mt = xhalf_max(mt);
      if (first || __any(mt > m[pl] + 8.f)) {
        const float mn = first ? mt : fmaxf(m[pl], mt);
        const float al = first ? 1.f : fexp2(m[pl] - mn);
        m[pl] = mn; lsum[pl] *= al;
#pragma unroll
        for (int i = 0; i < 16; i++) { O[pl][0][i] *= al; O[pl][1][i] *= al; }
      }
      const float mm = m[pl];
      float ls = 0.f;
#pragma unroll
      for (int kb = 0; kb < 2; kb++) {
#pragma unroll
        for (int i = 0; i < 16; i++) { float e = fexp2(st[kb][i] - mm); st[kb][i] = e; ls += e; }
#pragma unroll
        for (int s = 0; s < 2; s++)
#pragma unroll
          for (int q = 0; q < 4; q++) pb[kb][s][q] = pk2(st[kb][8 * s + 2 * q], st[kb][8 * s + 2 * q + 1]);
      }
      lsum[pl] += ls;
#pragma unroll
      for (int dt = 0; dt < 2; dt++)
#pragma unroll
        for (int kb = 0; kb < 2; kb++)
#pragma unroll
          for (int s = 0; s < 2; s++) {
            bf8 a = *(const bf8*)(Vb + (32 * dt + r) * LDT + 32 * kb + 16 * s + 8 * hh);
            O[pl][dt] = __builtin_amdgcn_mfma_f32_32x32x16_bf16(a, __builtin_bit_cast(bf8, pb[kb][s]), O[pl][dt], 0, 0, 0);
          }
      __builtin_amdgcn_sched_barrier(0);
    }
    if (kt + 1 < ntile) swrite(rkW, rvW, (kt + 1) & 1);
    __syncthreads();
  };
  for (int kt = 0; kt < ntile; kt += 2) {
    tile_body(kt, rkA, rvA, rkB, rvB);
    tile_body(kt + 1, rkB, rvB, rkA, rvA);
  }
  const float lam_init = 0.8f - 0.6f * __expf(-0.3f * (float)l);
  float d0 = 0.f, d1 = 0.f;
  for (int i = 0; i < 32; i++) {
    d0 += p.lam_q[(l * 2 + 0) * 32 + i] * p.lam_k[(l * 2 + 0) * 32 + i];
    d1 += p.lam_q[(l * 2 + 1) * 32 + i] * p.lam_k[(l * 2 + 1) * 32 + i];
  }
  const float lam = __expf(d0) - __expf(d1) + lam_init;
  const float i0 = 1.f / xhalf_sum(lsum[0]);
  const float i1 = lam / xhalf_sum(lsum[1]);
  float ss = 0.f;
#pragma unroll
  for (int dt = 0; dt < 2; dt++)
#pragma unroll
    for (int i = 0; i < 16; i++) { float o = O[0][dt][i] * i0 - O[1][dt][i] * i1; O[0][dt][i] = o; ss += o * o; }
  ss = xhalf_sum(ss);
  const float rs = rsqrtf(ss * (1.f / 64.f) + 1e-5f) * (1.f - lam_init);
  const float* gs = p.subln + l * 256 + hd * 64;
#pragma unroll
  for (int dt = 0; dt < 2; dt++)
#pragma unroll
    for (int i4 = 0; i4 < 4; i4++) {
      const int dv = 32 * dt + 8 * i4 + 4 * hh;
      u2 ov;
      ov[0] = pk2(O[0][dt][4 * i4 + 0] * rs * gs[dv + 0], O[0][dt][4 * i4 + 1] * rs * gs[dv + 1]);
      ov[1] = pk2(O[0][dt][4 * i4 + 2] * rs * gs[dv + 2], O[0][dt][4 * i4 + 3] * rs * gs[dv + 3]);
      *(u2*)(ACD + qrow * PACD + hd * 64 + dv) = ov;
    }
}

__device__ __forceinline__ void phase_m1(const Params& p, int l, unsigned char* smem) {
  const int NP = NR / 16, NC = 260 * 4;
  for (int it = blockIdx.x; it < NP + NC; it += gridDim.x) {
    if (it < NP) prepb_tile(p, l, it, (float*)smem);
    else retc1_item(p, l, it - NP, (float*)smem);
  }
}
__device__ __forceinline__ unsigned xb_xcc_id();
__device__ __forceinline__ void phase_m2(const Params& p, int l, unsigned char* smem) {
  __shared__ int s_item;
  unsigned* ctr = (unsigned*)(p.ws + OFF_CTR) + 16 * l;
  const int N0 = 4160, N1 = N0 + 1040, N2 = N1 + 128;
  for (;;) {
    if (threadIdx.x == 0) s_item = (int)atomicAdd(ctr, 1u);
    __syncthreads();
    const int it = s_item;
    __syncthreads();
    if (it >= N2) break;
    if (it < N0) rwkv_s1_item(p, it, (u16*)smem);
    else if (it < N1) attn_item<1>(p, l, it - N0, (u16*)smem);
    else retc2_item(p, l, it - N1);
  }
}
__device__ __forceinline__ void phase_m2b(const Params& p, int l, unsigned char* smem) {
  __shared__ int s_item2;
  unsigned* ctr = (unsigned*)(p.ws + OFF_CTR) + 16 * l;
  for (;;) {
    if (threadIdx.x == 0) s_item2 = (int)atomicAdd(ctr + 1, 1u);
    __syncthreads();
    const int it = s_item2;
    __syncthreads();
    if (it >= 8) break;
    rwkv_s2_item(p, it);
  }
  const int x0 = (int)(xb_xcc_id() & 7u);
  for (int dx = 0; dx < 8; dx++) {
    const int x = (x0 + dx) & 7;
    for (;;) {
      if (threadIdx.x == 0) s_item2 = (int)atomicAdd(ctr + 2 + x, 1u);
      __syncthreads();
      const int j = s_item2;
      __syncthreads();
      if (j >= 130) break;
      attnA2_item(p, l, j < 128 ? x * 128 + j : 1024 + x * 2 + (j - 128), (u16*)smem);
    }
  }
}
__device__ __forceinline__ void phase_m3(const Params& p, int l, unsigned char* smem) {
  const int NF = 2080, NC = 260 * 4;
  for (int it = blockIdx.x; it < NF + NC; it += gridDim.x) {
    if (it < NF) rwkv_s3_item(p, l, it, (u16*)smem);
    else retc3_item(p, l, it - NF, (u16*)smem);
  }
}

__device__ __forceinline__ void phase_merge(const Params& p, int l, unsigned char* smem) {
  const u16* H = (const u16*)(p.ws + OFF_H);
  const u16* winT = (const u16*)(p.ws + OFF_WA);
  const u16* wbrT = winT + (size_t)WINC * DM;
  const u16* ACD = (const u16*)(p.ws + OFF_ACD);
  const u16* GB = (const u16*)(p.ws + OFF_GB);
  u16* M = (u16*)(p.ws + OFF_M);
  GemmPipe1<2> pp;
  auto yptr = [&](int n, const u16*& yp, int& yl) {
    if (n == 0) { yp = ACD; yl = PACD; } else if (n == 1) { yp = GB; yl = 256; }
    else if (n == 2) { yp = ACD + 1280; yl = PACD; } else { yp = ACD + 1536; yl = PACD; }
  };
  int mt, nt;
  bool have = gemm_tile_of(0, 8, mt, nt);
  if (have) gemm_prefetch1<2>(pp, H + (size_t)mt * 128 * DM, DM, winT + ((size_t)3200 + nt * 128) * DM, DM);
  for (int kk = 0; have; kk++) {
    const int m0 = mt * 128, n0 = nt * 128;
    have = gemm_tile_of(kk + 1, 8, mt, nt);
    unsigned mpk[2][2][8];
#pragma unroll
    for (int mi = 0; mi < 2; mi++)
#pragma unroll
      for (int ni = 0; ni < 2; ni++)
#pragma unroll
        for (int i = 0; i < 8; i++) mpk[mi][ni][i] = 0u;
#pragma unroll 1
    for (int n = 0; n < 4; n++) {
      const u16* yp; int yl;
      yptr(n, yp, yl);
      unsigned sg[2][2][8];
      {
        f16 gacc[2][2];
        zero_acc<2>(gacc);
        gemm_main1<2>(gacc, pp, H + (size_t)m0 * DM, DM, winT + ((size_t)3200 + n * DM + n0) * DM, DM, DM, (u16*)smem);
        gemm_prefetch1<2>(pp, yp + (size_t)m0 * yl, yl, wbrT + ((size_t)n * DM + n0) * 256, 256);
#pragma unroll
        for (int mi = 0; mi < 2; mi++)
#pragma unroll
          for (int ni = 0; ni < 2; ni++)
#pragma unroll
            for (int i = 0; i < 8; i++) sg[mi][ni][i] = pk2(fsigmoid(gacc[mi][ni][2 * i]), fsigmoid(gacc[mi][ni][2 * i + 1]));
      }
      f16 yacc[2][2];
      zero_acc<2>(yacc);
      gemm_main1<2>(yacc, pp, yp + (size_t)m0 * yl, yl, wbrT + ((size_t)n * DM + n0) * 256, 256, 256, (u16*)smem);
      {
        int m0n = m0, n0n = n0, nn = n + 1;
        bool hv = true;
        if (nn == 4) { hv = have; m0n = mt * 128; n0n = nt * 128; nn = 0; }
        if (hv) gemm_prefetch1<2>(pp, H + (size_t)m0n * DM, DM, winT + ((size_t)3200 + nn * DM + n0n) * DM, DM);
      }
#pragma unroll
      for (int mi = 0; mi < 2; mi++)
#pragma unroll
        for (int ni = 0; ni < 2; ni++)
#pragma unroll
          for (int i = 0; i < 8; i++) {
            const float a = lo16(mpk[mi][ni][i]) + lo16(sg[mi][ni][i]) * yacc[mi][ni][2 * i];
            const float c2 = hi16(mpk[mi][ni][i]) + hi16(sg[mi][ni][i]) * yacc[mi][ni][2 * i + 1];
            mpk[mi][ni][i] = pk2(a, c2);
          }
    }
    f16 macc[2][2];
#pragma unroll
    for (int mi = 0; mi < 2; mi++)
#pragma unroll
      for (int ni = 0; ni < 2; ni++)
#pragma unroll
        for (int i = 0; i < 8; i++) { macc[mi][ni][2 * i] = lo16(mpk[mi][ni][i]); macc[mi][ni][2 * i + 1] = hi16(mpk[mi][ni][i]); }
    gemm_epi<2>(macc, (float*)smem, [&](int row, int c8, const float* e) {
      store8(M + (size_t)(m0 + row) * DM + n0 + c8, e);
    });
  }
}

template <int ACT>
__device__ __forceinline__ void phase_gemm(const u16* A, const u16* WT, u16* OUT, int N, int K, unsigned char* smem) {
  const int ntn = N >> 7;
  GemmPipe<2> pp;
  int mt, nt;
  bool have = gemm_tile_of(0, ntn, mt, nt);
  if (have) gemm_prefetch<2>(pp, A + (size_t)mt * 128 * K, K, WT + (size_t)nt * 128 * K, K);
  for (int kk = 0; have; kk++) {
    const int m0 = mt * 128, n0 = nt * 128;
    f16 acc[2][2];
    zero_acc<2>(acc);
    gemm_main<2>(acc, pp, A + (size_t)m0 * K, K, WT + (size_t)n0 * K, K, K, (u16*)smem);
    have = gemm_tile_of(kk + 1, ntn, mt, nt);
    if (have) gemm_prefetch<2>(pp, A + (size_t)mt * 128 * K, K, WT + (size_t)nt * 128 * K, K);
    gemm_epi<2>(acc, (float*)smem, [&](int row, int c8, const float* e) {
      float v[8];
#pragma unroll
      for (int i = 0; i < 8; i++) { float x = e[i]; if (ACT == 1) { x = fmaxf(x, 0.f); x = x * x; } v[i] = x; }
      store8(OUT + (size_t)(m0 + row) * N + n0 + c8, v);
    });
  }
}

__device__ __forceinline__ unsigned xb_xcc_id() { return (unsigned)__builtin_amdgcn_s_getreg((3 << 11) | 20) & 0xFu; }

constexpr int PH_PER_LAYER = 11;
constexpr int NPHASE = 2 + DEPTH * PH_PER_LAYER;

__device__ __forceinline__ void run_phase(const Params& p, int ph, unsigned char* smem) {
  if (ph == 0) { phase_pro(p, smem); return; }
  if (ph == 1) { phase_rows(p, 0, 0); return; }
  const int l = (ph - 2) / PH_PER_LAYER, s = (ph - 2) % PH_PER_LAYER;
  unsigned char* ws = p.ws;
  switch (s) {
    case 0: phase_gemm1(p, l, smem); break;
    case 1: phase_m1(p, l, smem); break;
    case 2: phase_m2(p, l, smem); break;
    case 3: phase_m2b(p, l, smem); break;
    case 4: phase_m3(p, l, smem); break;
    case 5: phase_merge(p, l, smem); break;
    case 6: phase_gemm<0>((const u16*)(ws + OFF_M), (const u16*)(ws + OFF_WA) + (size_t)WINC * DM + (size_t)4 * DM * 256,
                          (u16*)(ws + OFF_MO), DM, DM, smem); break;
    case 7: phase_rows(p, l, 1); break;
    case 8: phase_gemm<1>((const u16*)(ws + OFF_H), (const u16*)(ws + OFF_WM), (u16*)(ws + OFF_U), DFF, DM, smem); break;
    case 9: phase_gemm<0>((const u16*)(ws + OFF_U), (const u16*)(ws + OFF_WM) + (size_t)DFF * DM, (u16*)(ws + OFF_DN), DM, DFF, smem); break;
    case 10: phase_rows(p, l, 2); if (l + 1 < DEPTH) wconv_layer(p, l + 1, smem); break;
  }
}

__global__ void __launch_bounds__(256, 2) mega_kernel(Params p) {
  __shared__ __attribute__((aligned(16))) unsigned char smem[SMEM_BYTES];
  cg::grid_group grid = cg::this_grid();
  for (int ph = 0; ph < NPHASE; ph++) {
    run_phase(p, ph, smem);
    if (ph + 1 < NPHASE) {
      grid.sync();
    }
  }
}

#if MULTI_LAUNCH
__global__ void __launch_bounds__(256, 2) phase_kernel(Params p, int ph) {
  __shared__ __attribute__((aligned(16))) unsigned char smem[SMEM_BYTES];
  run_phase(p, ph, smem);
}
#endif

extern "C" void kernel_launch(void* const* d_in, const int* in_sizes, int n_in, void* d_out, int out_size, void* d_ws,
                              size_t ws_size, hipStream_t stream) {
  Params p{};
  const float** pp = (const float**)&p;
  for (int i = 0; i < 32; i++) pp[i] = (const float*)d_in[i];
  p.out = (float*)d_out;
  p.ws = (unsigned char*)d_ws;
#if MULTI_LAUNCH
  hipMemsetAsync((unsigned char*)d_ws + OFF_CTR, 0, 256, stream);
  for (int ph = 0; ph < NPHASE; ph++) phase_kernel<<<dim3(512), dim3(256), 0, stream>>>(p, ph);
#else
  static int grid_blocks = 0;
  if (!grid_blocks) {
    int dev = 0, cus = 0, per_cu = 0;
    hipGetDevice(&dev);
    hipDeviceGetAttribute(&cus, hipDeviceAttributeMultiprocessorCount, dev);
    hipOccupancyMaxActiveBlocksPerMultiprocessor(&per_cu, mega_kernel, 256, 0);
    if (per_cu > 2) per_cu = 2;
    if (per_cu < 1) per_cu = 1;
    grid_blocks = cus * per_cu;
  }
  (void)hipMemsetAsync((unsigned char*)d_ws + OFF_CTR, 0, 4096, stream);
  void* args[] = {&p};
  hipError_t e = hipLaunchCooperativeKernel((void*)mega_kernel, dim3(grid_blocks), dim3(256), args, 0, stream);
  if (e != hipSuccess) fprintf(stderr, "cooperative launch failed: %s (grid %d)\n", hipGetErrorString(e), grid_blocks);
#endif
}
```

```cpp
#include <hip/hip_runtime.h>
#include <hip/hip_cooperative_groups.h>
#include <stdint.h>
#include <stdio.h>
namespace cg = cooperative_groups;

typedef unsigned short u16;
typedef __attribute__((ext_vector_type(8))) __bf16 bf8;
typedef __attribute__((ext_vector_type(2))) __bf16 bf2;
typedef __attribute__((ext_vector_type(2))) float f2;
typedef __attribute__((ext_vector_type(4))) float f4;
typedef __attribute__((ext_vector_type(16))) float f16;
typedef __attribute__((ext_vector_type(4))) unsigned u4;
typedef __attribute__((ext_vector_type(2))) unsigned u2;

#ifndef MULTI_LAUNCH
#define MULTI_LAUNCH 0
#endif

constexpr int DM = 1024, NB = 2, SEQ = 16384, CTX = 256, TT = SEQ + CTX, NR = NB * TT, DEPTH = 4;
constexpr int WINC = 7296, DFF = 4096;
constexpr int PACD = 2048, PCB = 1152;
constexpr size_t MiB = 1u << 20;
constexpr size_t OFF_CTXRES = 0, OFF_MOD = 2 * MiB, OFF_CTR = 2 * MiB + 512 * 1024, OFF_TAB = 3 * MiB, OFF_WA = 6 * MiB,
                 OFF_H = 25 * MiB, OFF_ACD = 90 * MiB, OFF_CB = 220 * MiB, OFF_SCAN = 294 * MiB, OFF_GB = 441 * MiB,
                 OFF_DS = 458 * MiB, OFF_SIN = 475 * MiB, OFF_WM = 484 * MiB,
                 OFF_M = OFF_SCAN, OFF_MO = OFF_CB, OFF_U = 90 * MiB, OFF_DN = 360 * MiB;
constexpr size_t ARR = (size_t)NR * 256;
constexpr float LOG2E = 1.4426950408889634f;
constexpr int LDT = 72;
constexpr int EPS = 132;
constexpr int SMEM_BYTES = 2 * 2 * 128 * LDT * 2 + 5376;

struct Params {
  const float *x, *c, *ctx, *c_ctx, *ada_w, *ada_b, *n_pre_mix, *n_post_mix, *n_pre_mlp, *n_post_mlp, *w_in,
      *lam_q, *lam_k, *subln, *mu, *w0, *w2, *a0, *a2, *g2, *rkk, *rka, *rrk, *lnx_g, *lnx_b, *ret_decay, *ret_gn,
      *win_sink, *w_branch, *w_out, *w_up, *w_down;
  float* out;
  unsigned char* ws;
};

__device__ __forceinline__ float bf2f(u16 h) { return __uint_as_float(((unsigned)h) << 16); }
__device__ __forceinline__ unsigned pk2(float a, float b) {
  bf2 r = __builtin_convertvector((f2){a, b}, bf2);
  return __builtin_bit_cast(unsigned, r);
}
__device__ __forceinline__ u16 f2bf(float a) { return (u16)(pk2(a, 0.f) & 0xffffu); }
__device__ __forceinline__ float lo16(unsigned x) { return __uint_as_float(x << 16); }
__device__ __forceinline__ float hi16(unsigned x) { return __uint_as_float(x & 0xffff0000u); }
__device__ __forceinline__ void store8(u16* dst, const float* v) {
  u4 o;
  o[0] = pk2(v[0], v[1]); o[1] = pk2(v[2], v[3]); o[2] = pk2(v[4], v[5]); o[3] = pk2(v[6], v[7]);
  *(u4*)dst = o;
}
__device__ __forceinline__ float wsum(float x) {
  x += __builtin_bit_cast(float, __builtin_amdgcn_update_dpp(0, __builtin_bit_cast(int, x), 0xB1, 0xF, 0xF, true));
  x += __builtin_bit_cast(float, __builtin_amdgcn_update_dpp(0, __builtin_bit_cast(int, x), 0x4E, 0xF, 0xF, true));
  x += __builtin_bit_cast(float, __builtin_amdgcn_update_dpp(0, __builtin_bit_cast(int, x), 0x141, 0xF, 0xF, true));
  x += __builtin_bit_cast(float, __builtin_amdgcn_update_dpp(0, __builtin_bit_cast(int, x), 0x140, 0xF, 0xF, true));
  x += __builtin_bit_cast(float, __builtin_amdgcn_update_dpp(0, __builtin_bit_cast(int, x), 0x142, 0xA, 0xF, false));
  x += __builtin_bit_cast(float, __builtin_amdgcn_update_dpp(0, __builtin_bit_cast(int, x), 0x143, 0xC, 0xF, false));
  return __builtin_bit_cast(float, __builtin_amdgcn_readlane(__builtin_bit_cast(int, x), 63));
}
__device__ __forceinline__ float xhalf_max(float v) {
  auto r = __builtin_amdgcn_permlane32_swap(__float_as_uint(v), __float_as_uint(v), false, false);
  return fmaxf(__uint_as_float(r[0]), __uint_as_float(r[1]));
}
__device__ __forceinline__ float xhalf_sum(float v) {
  auto r = __builtin_amdgcn_permlane32_swap(__float_as_uint(v), __float_as_uint(v), false, false);
  return __uint_as_float(r[0]) + __uint_as_float(r[1]);
}
__device__ __forceinline__ int ltid() { int t = threadIdx.x; asm volatile("" : "+v"(t)); return t; }
__device__ __forceinline__ float fexp2(float x) { return __builtin_amdgcn_exp2f(x); }
__device__ __forceinline__ float fsigmoid(float x) { return __builtin_amdgcn_rcpf(1.f + fexp2(-x * LOG2E)); }
__device__ __forceinline__ int swz23(int r) { return (r & 0x13) | ((r & 4) << 1) | ((r & 8) >> 1); }

__device__ __forceinline__ float* xrow(const Params& p, int row) {
  int b = row >= TT ? 1 : 0;
  int t = row - b * TT;
  if (t < CTX) return (float*)(p.ws + OFF_CTXRES) + (size_t)(b * CTX + t) * DM;
  return p.out + (size_t)(b * SEQ + t - CTX) * DM;
}
__device__ __forceinline__ const float* xrow_in(const Params& p, int row) {
  int b = row >= TT ? 1 : 0;
  int t = row - b * TT;
  if (t < CTX) return p.ctx + (size_t)(b * CTX + t) * DM;
  return p.x + (size_t)(b * SEQ + t - CTX) * DM;
}
__device__ __forceinline__ const float* modrow(const Params& p, int layer, int row) {
  int b = row >= TT ? 1 : 0;
  int t = row - b * TT;
  int which = t < CTX ? 2 : b;
  return (const float*)(p.ws + OFF_MOD) + (size_t)(layer * 3 + which) * 6 * DM;
}

__device__ __forceinline__ bool gemm_tile_of(int k, int ntn, int& mt, int& nt) {
  const int x = blockIdx.x & 7, lb = blockIdx.x >> 3, nlb = gridDim.x >> 3;
  const int mstart = x * 32 + (x < 4 ? x : 4), mcount = 32 + (x < 4 ? 1 : 0);
  const int j = lb + k * nlb;
  if (j >= mcount * ntn) return false;
  int mg, rm, jj;
  if (j < 32 * ntn) { mg = j / (8 * ntn); rm = 8; jj = j - mg * 8 * ntn; }
  else { mg = 4; rm = 1; jj = j - 32 * ntn; }
  nt = jj / rm;
  mt = mstart + mg * 8 + (jj - nt * rm);
  return true;
}

template <int NI>
struct GemmPipe { u4 ra0[4], rb0[2 * NI], ra1[4], rb1[2 * NI]; };

template <int NI>
__device__ __forceinline__ void gemm_prefetch(GemmPipe<NI>& pp, const u16* __restrict__ A, int lda,
                                              const u16* __restrict__ B, int ldb) {
  const int tid = ltid();
  const int crow = tid >> 3, ckc = (tid & 7) * 8;
  const u16* Ap = A + (size_t)crow * lda + ckc;
  const u16* Bp = B + (size_t)crow * ldb + ckc;
  const size_t astep = (size_t)32 * lda, bstep = (size_t)32 * ldb;
#pragma unroll
  for (int i = 0; i < 4; i++) { pp.ra0[i] = *(const u4*)(Ap + i * astep); pp.ra1[i] = *(const u4*)(Ap + i * astep + 64); }
#pragma unroll
  for (int i = 0; i < 2 * NI; i++) { pp.rb0[i] = *(const u4*)(Bp + i * bstep); pp.rb1[i] = *(const u4*)(Bp + i * bstep + 64); }
}

template <int NI>
__device__ __forceinline__ void gemm_main(f16 (&acc)[2][NI], GemmPipe<NI>& pp, const u16* __restrict__ A, int lda,
                                          const u16* __restrict__ B, int ldb, int K, u16* sm) {
  const int tid = ltid(), lane = tid & 63, wid = tid >> 6, wm = wid >> 1, wn = wid & 1;
  const int r = lane & 31, hh = lane >> 5;
  u16* sa = sm;
  u16* sb = sm + 2 * 128 * LDT;
  const int nk = K >> 6;
  const int crow = tid >> 3, ckc = (tid & 7) * 8;
  const u16* Ap = A + (size_t)crow * lda + ckc;
  const u16* Bp = B + (size_t)crow * ldb + ckc;
  const size_t astep = (size_t)32 * lda, bstep = (size_t)32 * ldb;
  auto gload = [&](u4 (&ra)[4], u4 (&rb)[2 * NI], int kt) {
#pragma unroll
    for (int i = 0; i < 4; i++) ra[i] = *(const u4*)(Ap + i * astep + kt * 64);
#pragma unroll
    for (int i = 0; i < 2 * NI; i++) rb[i] = *(const u4*)(Bp + i * bstep + kt * 64);
  };
  auto swrite = [&](const u4 (&ra)[4], const u4 (&rb)[2 * NI], int buf) {
    const int nb = buf * 128 * LDT;
#pragma unroll
    for (int i = 0; i < 4; i++) *(u4*)(sa + nb + (crow + 32 * i) * LDT + ckc) = ra[i];
#pragma unroll
    for (int i = 0; i < 2 * NI; i++) *(u4*)(sb + nb + (crow + 32 * i) * LDT + ckc) = rb[i];
  };
  auto compute = [&](int buf) {
    const u16* a0 = sa + buf * 128 * LDT + (64 * wm + r) * LDT + 8 * hh;
    const u16* b0 = sb + buf * 128 * LDT + (32 * NI * wn + r) * LDT + 8 * hh;
#pragma unroll
    for (int s = 0; s < 4; s++) {
      bf8 af[2], bfr[NI];
#pragma unroll
      for (int mi = 0; mi < 2; mi++) af[mi] = *(const bf8*)(a0 + mi * 32 * LDT + 16 * s);
#pragma unroll
      for (int ni = 0; ni < NI; ni++) bfr[ni] = *(const bf8*)(b0 + ni * 32 * LDT + 16 * s);
#pragma unroll
      for (int mi = 0; mi < 2; mi++)
#pragma unroll
        for (int ni = 0; ni < NI; ni++)
          acc[mi][ni] = __builtin_amdgcn_mfma_f32_32x32x16_bf16(af[mi], bfr[ni], acc[mi][ni], 0, 0, 0);
    }
  };
  swrite(pp.ra0, pp.rb0, 0);
  __syncthreads();
  for (int kt = 0; kt < nk; kt += 2) {
    if (kt + 2 < nk) gload(pp.ra0, pp.rb0, kt + 2);
    compute(0);
    swrite(pp.ra1, pp.rb1, 1);
    __syncthreads();
    if (kt + 3 < nk) gload(pp.ra1, pp.rb1, kt + 3);
    compute(1);
    if (kt + 2 < nk) swrite(pp.ra0, pp.rb0, 0);
    __syncthreads();
  }
}

template <int NI>
struct GemmPipe1 { u4 ra[4], rb[2 * NI]; };
template <int NI>
__device__ __forceinline__ void gemm_prefetch1(GemmPipe1<NI>& pp, const u16* __restrict__ A, int lda,
                                               const u16* __restrict__ B, int ldb) {
  const int tid = ltid();
  const int crow = tid >> 3, ckc = (tid & 7) * 8;
#pragma unroll
  for (int i = 0; i < 4; i++) pp.ra[i] = *(const u4*)(A + (size_t)(crow + 32 * i) * lda + ckc);
#pragma unroll
  for (int i = 0; i < 2 * NI; i++) pp.rb[i] = *(const u4*)(B + (size_t)(crow + 32 * i) * ldb + ckc);
}
template <int NI>
__device__ __forceinline__ void gemm_main1(f16 (&acc)[2][NI], GemmPipe1<NI>& pp, const u16* __restrict__ A, int lda,
                                           const u16* __restrict__ B, int ldb, int K, u16* sm) {
  const int tid = ltid(), lane = tid & 63, wid = tid >> 6, wm = wid >> 1, wn = wid & 1;
  const int r = lane & 31, hh = lane >> 5;
  u16* sa = sm;
  u16* sb = sm + 2 * 128 * LDT;
  const int nk = K >> 6;
  const int crow = tid >> 3, ckc = (tid & 7) * 8;
  const u16* Ap = A + (size_t)crow * lda + ckc;
  const u16* Bp = B + (size_t)crow * ldb + ckc;
  const size_t astep = (size_t)32 * lda, bstep = (size_t)32 * ldb;
  auto swrite = [&](int buf) {
    const int nb = buf * 128 * LDT;
#pragma unroll
    for (int i = 0; i < 4; i++) *(u4*)(sa + nb + (crow + 32 * i) * LDT + ckc) = pp.ra[i];
#pragma unroll
    for (int i = 0; i < 2 * NI; i++) *(u4*)(sb + nb + (crow + 32 * i) * LDT + ckc) = pp.rb[i];
  };
  swrite(0);
  __syncthreads();
  for (int kt = 0; kt < nk; kt++) {
    if (kt + 1 < nk) {
#pragma unroll
      for (int i = 0; i < 4; i++) pp.ra[i] = *(const u4*)(Ap + i * astep + (kt + 1) * 64);
#pragma unroll
      for (int i = 0; i < 2 * NI; i++) pp.rb[i] = *(const u4*)(Bp + i * bstep + (kt + 1) * 64);
    }
    const u16* a0 = sa + (kt & 1) * 128 * LDT + (64 * wm + r) * LDT + 8 * hh;
    const u16* b0 = sb + (kt & 1) * 128 * LDT + (32 * NI * wn + r) * LDT + 8 * hh;
#pragma unroll
    for (int s = 0; s < 4; s++) {
      bf8 af[2], bfr[NI];
#pragma unroll
      for (int mi = 0; mi < 2; mi++) af[mi] = *(const bf8*)(a0 + mi * 32 * LDT + 16 * s);
#pragma unroll
      for (int ni = 0; ni < NI; ni++) bfr[ni] = *(const bf8*)(b0 + ni * 32 * LDT + 16 * s);
#pragma unroll
      for (int mi = 0; mi < 2; mi++)
#pragma unroll
        for (int ni = 0; ni < NI; ni++)
          acc[mi][ni] = __builtin_amdgcn_mfma_f32_32x32x16_bf16(af[mi], bfr[ni], acc[mi][ni], 0, 0, 0);
    }
    if (kt + 1 < nk) swrite((kt + 1) & 1);
    __syncthreads();
  }
}

template <int NI, class F>
__device__ __forceinline__ void gemm_epi(f16 (&acc)[2][NI], float* ep, F&& f) {
  const int tid = ltid(), lane = tid & 63, wid = tid >> 6, wm = wid >> 1, wn = wid & 1;
  const int r = lane & 31, hh = lane >> 5;
#pragma unroll
  for (int mi = 0; mi < 2; mi++)
#pragma unroll
    for (int ni = 0; ni < NI; ni++)
#pragma unroll
      for (int i = 0; i < 16; i++) {
        int row = 64 * wm + 32 * mi + (i & 3) + 8 * (i >> 2) + 4 * hh;
        int col = 32 * NI * wn + 32 * ni + r;
        ep[row * EPS + col] = acc[mi][ni][i];
      }
  __syncthreads();
  constexpr int CG = 8 * NI;
  for (int u = tid; u < 128 * CG; u += 256) {
    int row = u / CG, c8 = (u % CG) * 8;
    f(row, c8, ep + row * EPS + c8);
  }
  __syncthreads();
}

template <int NI>
__device__ __forceinline__ void zero_acc(f16 (&acc)[2][NI]) {
#pragma unroll
  for (int mi = 0; mi < 2; mi++)
#pragma unroll
    for (int ni = 0; ni < NI; ni++)
#pragma unroll
      for (int i = 0; i < 16; i++) acc[mi][ni][i] = 0.f;
}

__device__ __forceinline__ void wconv_tile(const float* __restrict__ src, u16* __restrict__ dst, int K, int N, int idx, float* tl) {
  const int tid = ltid();
  const int ntn = N >> 6;
  const int kt = idx / ntn, nt = idx - kt * ntn;
  const int k0 = kt * 64, n0 = nt * 64;
  const int a = tid >> 6, bb = tid & 63;
  float wv[16];
#pragma unroll
  for (int i = 0; i < 16; i++) wv[i] = src[(size_t)(k0 + i * 4 + a) * N + n0 + bb];
#pragma unroll
  for (int i = 0; i < 16; i++) tl[(i * 4 + a) * 65 + bb] = wv[i];
  __syncthreads();
#pragma unroll 4
  for (int i = 0; i < 16; i++) {
    int n = i * 4 + a;
    dst[(size_t)(n0 + n) * K + k0 + bb] = f2bf(tl[bb * 65 + n]);
  }
  __syncthreads();
}

__device__ __forceinline__ void wconv_layer(const Params& p, int l, unsigned char* smem) {
  float* tl = (float*)smem;
  u16* winT = (u16*)(p.ws + OFF_WA);
  u16* wbrT = winT + (size_t)WINC * DM;
  u16* woutT = wbrT + (size_t)4 * DM * 256;
  u16* wupT = (u16*)(p.ws + OFF_WM);
  u16* wdnT = wupT + (size_t)DFF * DM;
  const int n0 = 1824, n1 = n0 + 256, n2 = n1 + 256, n3 = n2 + 1024, n4 = n3 + 1024;
  for (int it = blockIdx.x; it < n4; it += gridDim.x) {
    if (it < n0) wconv_tile(p.w_in + (size_t)l * DM * WINC, winT, DM, WINC, it, tl);
    else if (it < n1) {
      int j = it - n0, n = j >> 6;
      wconv_tile(p.w_branch + ((size_t)l * 4 + n) * 256 * DM, wbrT + (size_t)n * DM * 256, 256, DM, j & 63, tl);
    } else if (it < n2) wconv_tile(p.w_out + (size_t)l * DM * DM, woutT, DM, DM, it - n1, tl);
    else if (it < n3) wconv_tile(p.w_up + (size_t)l * DM * DFF, wupT, DM, DFF, it - n2, tl);
    else wconv_tile(p.w_down + (size_t)l * DFF * DM, wdnT, DFF, DM, it - n3, tl);
  }
}

__device__ __forceinline__ void phase_pro(const Params& p, unsigned char* smem) {
  const int tid = ltid(), lane = tid & 63, wid = tid >> 6;
  float* sil = (float*)smem;
  float* red = sil + 3 * DM;
  float* modv = (float*)(p.ws + OFF_MOD);
  for (int it = blockIdx.x; it < DEPTH * 96; it += gridDim.x) {
    int l = it / 96, cgp = it - l * 96;
    for (int i = tid; i < 3 * DM; i += 256) {
      int w = i >> 10, k = i & 1023;
      float v = w < 2 ? p.c[w * DM + k] : p.c_ctx[k];
      sil[i] = v * fsigmoid(v);
    }
    __syncthreads();
    const float* W = p.ada_w + (size_t)l * DM * 6 * DM + cgp * 64 + lane;
    float a0 = 0.f, a1 = 0.f, a2 = 0.f;
#pragma unroll 16
    for (int k = wid * 256; k < wid * 256 + 256; k++) {
      float w = W[(size_t)k * 6 * DM];
      a0 += sil[k] * w; a1 += sil[DM + k] * w; a2 += sil[2 * DM + k] * w;
    }
    red[(wid * 3 + 0) * 64 + lane] = a0; red[(wid * 3 + 1) * 64 + lane] = a1; red[(wid * 3 + 2) * 64 + lane] = a2;
    __syncthreads();
    if (tid < 192) {
      int w = tid >> 6;
      float s = red[(0 * 3 + w) * 64 + lane] + red[(1 * 3 + w) * 64 + lane] + red[(2 * 3 + w) * 64 + lane] + red[(3 * 3 + w) * 64 + lane];
      int col = cgp * 64 + lane;
      modv[(size_t)(l * 3 + w) * 6 * DM + col] = s + p.ada_b[(size_t)l * 6 * DM + col];
    }
    __syncthreads();
  }
  const size_t gtid = (size_t)blockIdx.x * 256 + tid, gsz = (size_t)gridDim.x * 256;
  {
    f2* tabC = (f2*)(p.ws + OFF_TAB);
    f2* tabAr = tabC + 16384 * 16; f2* tabAc = tabAr + 256 * 8; f2* tabDr = tabAc + 64 * 8; f2* tabDc = tabDr + 256 * 16;
    const int total = 16384 * 16 + 256 * 8 + 64 * 8 + 256 * 16 + 64 * 16;
    for (size_t i = gtid; i < (size_t)total; i += gsz) {
      int e = (int)i; int pos, j, nf; f2* dst;
      if (e < 16384 * 16) { pos = e >> 4; j = e & 15; nf = 16; dst = tabC + e; }
      else if ((e -= 16384 * 16) < 256 * 8) { pos = e >> 3; j = e & 7; nf = 8; dst = tabAr + e; }
      else if ((e -= 256 * 8) < 64 * 8) { pos = e >> 3; j = e & 7; nf = 8; dst = tabAc + e; }
      else if ((e -= 64 * 8) < 256 * 16) { pos = e >> 4; j = e & 15; nf = 16; dst = tabDr + e; }
      else { e -= 256 * 16; pos = e >> 4; j = e & 15; nf = 16; dst = tabDc + e; }
      double base = nf == 8 ? 0.31622776601683794 : 0.5623413251903491;
      double f = 1.0;
      for (int q = 0; q < j; q++) f *= base;
      float inv = (float)f;
      float ang = (float)pos * inv;
      double rev = (double)ang * 0.15915494309189535;
      rev -= floor(rev);
      float rv = (float)rev;
      f2 cs; cs.x = __builtin_amdgcn_cosf(rv); cs.y = __builtin_amdgcn_sinf(rv);
      *dst = cs;
    }
  }
  wconv_layer(p, 0, smem);
}

__device__ __forceinline__ void phase_rows(const Params& p, int l, int mode) {
  const int tid = ltid(), lane = tid & 63, wid = __builtin_amdgcn_readfirstlane(tid >> 6);
  u16* H = (u16*)(p.ws + OFF_H);
  const u16* src = (const u16*)(p.ws + (mode == 1 ? OFF_MO : OFF_DN));
  for (int row = blockIdx.x * 4 + wid; row < NR; row += gridDim.x * 4) {
    float* xr = xrow(p, row);
    const float* xsrc = (l == 0 && mode <= 1) ? xrow_in(p, row) : xr;
    f4 xv[4];
#pragma unroll
    for (int i = 0; i < 4; i++) xv[i] = *(const f4*)(xsrc + lane * 4 + 256 * i);
    if (mode != 0) {
      const float* md = modrow(p, l, row);
      const float* gt = md + (mode == 1 ? 2 : 5) * DM;
      const float* gpost = (mode == 1 ? p.n_post_mix : p.n_post_mlp) + (size_t)l * DM;
      float mv[4][4]; float ss = 0.f;
#pragma unroll
      for (int i = 0; i < 4; i++) {
        u2 raw = *(const u2*)(src + (size_t)row * DM + lane * 4 + 256 * i);
        mv[i][0] = lo16(raw[0]); mv[i][1] = hi16(raw[0]); mv[i][2] = lo16(raw[1]); mv[i][3] = hi16(raw[1]);
#pragma unroll
        for (int j = 0; j < 4; j++) ss += mv[i][j] * mv[i][j];
      }
      ss = wsum(ss);
      float rs = rsqrtf(ss * (1.f / DM) + 1e-6f);
#pragma unroll
      for (int i = 0; i < 4; i++) {
        f4 g4 = *(const f4*)(gpost + lane * 4 + 256 * i);
        f4 t4 = *(const f4*)(gt + lane * 4 + 256 * i);
#pragma unroll
        for (int j = 0; j < 4; j++) xv[i][j] += t4[j] * (mv[i][j] * rs * g4[j]);
        *(f4*)(xr + lane * 4 + 256 * i) = xv[i];
      }
    }
    int ln = mode == 2 ? l + 1 : l;
    if (ln < DEPTH) {
      const float* md = modrow(p, ln, row);
      const float* sh = md + (mode == 1 ? 3 : 0) * DM;
      const float* sc = md + (mode == 1 ? 4 : 1) * DM;
      const float* gpre = (mode == 1 ? p.n_pre_mlp : p.n_pre_mix) + (size_t)ln * DM;
      float ss = 0.f;
#pragma unroll
      for (int i = 0; i < 4; i++)
#pragma unroll
        for (int j = 0; j < 4; j++) ss += xv[i][j] * xv[i][j];
      ss = wsum(ss);
      float rs = rsqrtf(ss * (1.f / DM) + 1e-6f);
#pragma unroll
      for (int i = 0; i < 4; i++) {
        f4 g4 = *(const f4*)(gpre + lane * 4 + 256 * i);
        f4 s4 = *(const f4*)(sh + lane * 4 + 256 * i);
        f4 c4 = *(const f4*)(sc + lane * 4 + 256 * i);
        float o[4];
#pragma unroll
        for (int j = 0; j < 4; j++) o[j] = xv[i][j] * rs * g4[j] * (1.f + c4[j]) + s4[j];
        u2 pk; pk[0] = pk2(o[0], o[1]); pk[1] = pk2(o[2], o[3]);
        *(u2*)(H + (size_t)row * DM + lane * 4 + 256 * i) = pk;
      }
    }
  }
}

__device__ __forceinline__ void phase_gemm1(const Params& p, int l, unsigned char* smem) {
  const u16* H = (const u16*)(p.ws + OFF_H);
  const u16* winT = (const u16*)(p.ws + OFF_WA);
  u16* ACD = (u16*)(p.ws + OFF_ACD);
  u16* CB = (u16*)(p.ws + OFF_CB);
  const f2* tabC = (const f2*)(p.ws + OFF_TAB);
  const f2* tabAr = tabC + 16384 * 16; const f2* tabAc = tabAr + 256 * 8; const f2* tabDr = tabAc + 64 * 8; const f2* tabDc = tabDr + 256 * 16;
  GemmPipe<2> pp;
  int mt, nt;
  bool have = gemm_tile_of(0, 25, mt, nt);
  if (have) gemm_prefetch<2>(pp, H + (size_t)mt * 128 * DM, DM, winT + (size_t)nt * 128 * DM, DM);
  for (int kk = 0; have; kk++) {
    const int m0 = mt * 128, n0 = nt * 128;
    f16 acc[2][2];
    zero_acc<2>(acc);
    gemm_main<2>(acc, pp, H + (size_t)m0 * DM, DM, winT + (size_t)n0 * DM, DM, DM, (u16*)smem);
    const int ntc = nt;
    have = gemm_tile_of(kk + 1, 25, mt, nt);
    if (have) gemm_prefetch<2>(pp, H + (size_t)mt * 128 * DM, DM, winT + (size_t)nt * 128 * DM, DM);
    {
      const int nt = ntc;
    int cls; float scale = 1.f; u16* dst; int dpitch;
    if (nt < 4) { cls = 1; if (nt < 2) scale = 0.17677669529663687f * LOG2E; }
    else if (nt == 15 || nt == 16) { cls = 2; if (nt == 16) scale = 0.17677669529663687f; }
    else if (nt >= 21 && nt < 24) { cls = 3; if (nt < 23) scale = 0.125f * LOG2E; }
    else cls = 0;
    if (n0 < 768) { dst = ACD + n0; dpitch = PACD; }
    else if (n0 < 1920) { dst = CB + (n0 - 768); dpitch = PCB; }
    else { dst = ACD + (n0 - 1152); dpitch = PACD; }
    gemm_epi<2>(acc, (float*)smem, [&](int row, int c8, const float* e) {
      const int grow = m0 + row;
      const int b = grow >= TT ? 1 : 0;
      const int t = grow - b * TT;
      float v[8];
      if (cls == 0 || t < CTX) {
#pragma unroll
        for (int i = 0; i < 8; i++) v[i] = e[i] * scale;
      } else {
        const int n = t - CTX;
        const f2* tb; bool first; int dist;
        if (cls == 1) { int ee = c8 & 31; int half = ee >> 4; first = (ee & 15) < 8; dist = 8; tb = half ? tabAc + (n & 63) * 8 : tabAr + (n >> 6) * 8; }
        else if (cls == 2) { int ee = c8 & 31; first = ee < 16; dist = 16; tb = tabC + n * 16 + (ee & 15); }
        else { int ee = c8 & 63; int half = ee >> 5; int i0 = ee & 31; first = i0 < 16; dist = 16; tb = (half ? tabDc + (n & 63) * 16 : tabDr + (n >> 6) * 16) + (i0 & 15); }
#pragma unroll
        for (int i = 0; i < 8; i++) {
          f2 cs = tb[i];
          float pp = first ? -e[i + dist] : e[i - dist];
          v[i] = (e[i] * cs.x + pp * cs.y) * scale;
        }
      }
      store8(dst + (size_t)grow * dpitch + c8, v);
    });
    }
  }
}

__device__ __forceinline__ void prepb_tile(const Params& p, int l, int tile, float* act) {
  const int c = ltid(), lane = c & 63;
  const u16* CB = (const u16*)(p.ws + OFF_CB);
  u16* scan = (u16*)(p.ws + OFF_SCAN);
  u16* GB = (u16*)(p.ws + OFF_GB);
  const int r0 = tile * 16;
  const int b = r0 >= TT ? 1 : 0;
  const int t0 = r0 - b * TT;
  const int seg0 = t0 < CTX ? 0 : CTX, seg1 = t0 < CTX ? CTX : TT;
  const float* mu = p.mu + (size_t)l * PCB;
  const float mu0 = mu[c], mu1 = mu[256 + c], mu2 = mu[512 + c], mu3 = mu[768 + c], mu4 = c < 128 ? mu[1024 + c] : 0.f;
  const float ckk = p.rkk[l * 256 + c], cka = p.rka[l * 256 + c];
  float* kls = act + 16 * 384;
  float* kkls = kls + 16 * 256;
  u16 raw[18][5];
#pragma unroll
  for (int j = 0; j < 18; j++) {
    const int t = t0 - 1 + j;
    const bool ok = t >= seg0 && t < seg1;
    const u16* rp = CB + (size_t)(b * TT + (ok ? t : t0)) * PCB;
    raw[j][0] = rp[c]; raw[j][1] = rp[256 + c]; raw[j][2] = rp[512 + c]; raw[j][3] = rp[768 + c];
    raw[j][4] = rp[1024 + (c & 127)];
    if (!ok) { raw[j][0] = 0; raw[j][1] = 0; raw[j][2] = 0; raw[j][3] = 0; raw[j][4] = 0; }
  }
#pragma unroll
  for (int j = 0; j < 16; j++) {
    const int t = t0 + j;
    const size_t orow = (size_t)(b * TT + t) * 256;
    const float cu0 = bf2f(raw[j + 1][0]), cu1 = bf2f(raw[j + 1][1]), cu2 = bf2f(raw[j + 1][2]), cu3 = bf2f(raw[j + 1][3]), cu4 = bf2f(raw[j + 1][4]);
    const float sm0 = 0.5f * (bf2f(raw[j][0]) + bf2f(raw[j + 2][0])), sm1 = 0.5f * (bf2f(raw[j][1]) + bf2f(raw[j + 2][1]));
    const float sm2 = 0.5f * (bf2f(raw[j][2]) + bf2f(raw[j + 2][2])), sm3 = 0.5f * (bf2f(raw[j][3]) + bf2f(raw[j + 2][3]));
    const float sm4 = 0.5f * (bf2f(raw[j][4]) + bf2f(raw[j + 2][4]));
    float xr = cu0 + (sm0 - cu0) * mu0;
    float xk = cu1 + (sm1 - cu1) * mu1;
    float xv = cu2 + (sm2 - cu2) * mu2;
    float x3 = cu3 + (sm3 - cu3) * mu3;
    float x4 = cu4 + (sm4 - cu4) * mu4;
    scan[0 * ARR + orow + c] = f2bf(xr);
    scan[1 * ARR + orow + c] = f2bf(xv);
    kls[j * 256 + c] = xk;
    float kk = xk * ckk;
    float ssq = wsum(kk * kk);
    kk *= rsqrtf(fmaxf(ssq, 1e-12f));
    kkls[j * 256 + c] = kk;
    scan[2 * ARR + orow + c] = f2bf(kk);
    act[j * 384 + c] = c < 128 ? (1.f - 2.f * __builtin_amdgcn_rcpf(1.f + __expf(2.f * x3))) : x3;
    if (c < 128) act[j * 384 + 256 + c] = fsigmoid(x4);
  }
  __syncthreads();
  const size_t obase = (size_t)(b * TT + t0) * 256 + c;
  {
    auto wptr = [&](int idx) -> const float* {
      if (idx < 8) {
        const int d = idx >> 2, isa = (idx >> 1) & 1, hf = idx & 1;
        return (isa ? p.a2 : p.w2) + ((size_t)(l * 2 + d) * 64 + hf * 32) * 256 + c;
      }
      return p.g2 + ((size_t)l * 128 + (idx - 8) * 32) * 256 + c;
    };
    auto aoff = [&](int idx) -> int {
      if (idx < 8) { const int d = idx >> 2, isa = (idx >> 1) & 1, hf = idx & 1; return (isa ? 128 : 0) + d * 64 + hf * 32; }
      return 256 + (idx - 8) * 32;
    };
    float wA[32], wB[32], acc[16];
#pragma unroll
    for (int k = 0; k < 32; k++) wA[k] = wptr(0)[k * 256];
#pragma unroll
    for (int j = 0; j < 16; j++) acc[j] = 0.f;
#pragma unroll
    for (int idx = 0; idx < 12; idx++) {
      if (idx + 1 < 12) {
        const float* wp = wptr(idx + 1);
        if ((idx & 1) == 0) {
#pragma unroll
          for (int k = 0; k < 32; k++) wB[k] = wp[k * 256];
        } else {
#pragma unroll
          for (int k = 0; k < 32; k++) wA[k] = wp[k * 256];
        }
      }
      const int ao = aoff(idx);
#pragma unroll
      for (int k = 0; k < 32; k += 4) {
#pragma unroll
        for (int j = 0; j < 16; j++) {
          f4 a = *(const f4*)(act + j * 384 + ao + k);
          if ((idx & 1) == 0) acc[j] += a[0] * wA[k] + a[1] * wA[k + 1] + a[2] * wA[k + 2] + a[3] * wA[k + 3];
          else acc[j] += a[0] * wB[k] + a[1] * wB[k + 1] + a[2] * wB[k + 2] + a[3] * wB[k + 3];
        }
      }
      if (idx == 1 || idx == 5) {
        const int d = idx >> 2;
        const float w0c = p.w0[(l * 2 + d) * 256 + c];
#pragma unroll
        for (int j = 0; j < 16; j++) {
          float xx = -(w0c + acc[j]);
          float sp = fmaxf(xx, 0.f) + __logf(1.f + __expf(-fabsf(xx)));
          float wlog = -sp - 0.5f;
          float lam = __expf(wlog) * LOG2E;
          scan[(3 + 3 * d) * ARR + obase + (size_t)j * 256] = f2bf(lam);
          acc[j] = 0.f;
        }
      } else if (idx == 3 || idx == 7) {
        const int d = idx >> 2;
        const float a0c = p.a0[(l * 2 + d) * 256 + c];
#pragma unroll
        for (int j = 0; j < 16; j++) {
          float a = fsigmoid(a0c + acc[j]);
          float kd = kls[j * 256 + c] * (1.f + (a - 1.f) * cka);
          scan[(4 + 3 * d) * ARR + obase + (size_t)j * 256] = f2bf(kd);
          scan[(5 + 3 * d) * ARR + obase + (size_t)j * 256] = f2bf(kkls[j * 256 + c] * a);
          acc[j] = 0.f;
        }
      } else if (idx == 11) {
#pragma unroll
        for (int j = 0; j < 16; j++) GB[obase + (size_t)j * 256] = f2bf(acc[j]);
      }
    }
  }
  __syncthreads();
}

__device__ __forceinline__ float ret_lg(const Params& p, int l, int d, int h) {
  float x = p.ret_decay[(l * 2 + d) * 4 + h];
  return -__log2f(1.f + __expf(-x));
}
__device__ __forceinline__ void retc1_item(const Params& p, int l, int item, float* sm) {
  const int tid = ltid();
  const int h = item & 3, bb = item >> 2;
  const int b = bb / 130, blk = bb - b * 130;
  const u16* ACD = (const u16*)(p.ws + OFF_ACD);
  float* Ks = sm;
  float* Vs = sm + 128 * 32;
  float* dec = Vs + 128 * 64;
  const size_t row0 = (size_t)b * TT + blk * 128;
  const float lgf = ret_lg(p, l, 0, h), lgb = ret_lg(p, l, 1, h);
  {
    u4 kv[2], vv[4];
#pragma unroll
    for (int i = 0; i < 2; i++) { const int ch = tid + 256 * i; kv[i] = *(const u4*)(ACD + (row0 + (ch >> 2)) * PACD + 896 + h * 32 + (ch & 3) * 8); }
#pragma unroll
    for (int i = 0; i < 4; i++) { const int ch = tid + 256 * i; vv[i] = *(const u4*)(ACD + (row0 + (ch >> 3)) * PACD + 1024 + h * 64 + (ch & 7) * 8); }
#pragma unroll
    for (int i = 0; i < 2; i++) {
      const int ch = tid + 256 * i, j = ch >> 2, q8 = (ch & 3) * 8;
#pragma unroll
      for (int e = 0; e < 4; e++) { Ks[j * 32 + q8 + 2 * e] = lo16(kv[i][e]); Ks[j * 32 + q8 + 2 * e + 1] = hi16(kv[i][e]); }
    }
#pragma unroll
    for (int i = 0; i < 4; i++) {
      const int ch = tid + 256 * i, j = ch >> 3, q8 = (ch & 7) * 8;
#pragma unroll
      for (int e = 0; e < 4; e++) { Vs[j * 64 + q8 + 2 * e] = lo16(vv[i][e]); Vs[j * 64 + q8 + 2 * e + 1] = hi16(vv[i][e]); }
    }
  }
  if (tid < 128) { dec[tid] = fexp2((127 - tid) * lgf); dec[128 + tid] = fexp2(tid * lgb); }
  __syncthreads();
  const int dv = tid & 63, dkg = tid >> 6;
  float af[8], ab[8];
#pragma unroll
  for (int i = 0; i < 8; i++) { af[i] = 0.f; ab[i] = 0.f; }
  for (int j = 0; j < 128; j++) {
    float v = Vs[j * 64 + dv];
    float vf = v * dec[j], vb = v * dec[128 + j];
    f4 k0 = *(const f4*)(Ks + j * 32 + dkg * 8), k1 = *(const f4*)(Ks + j * 32 + dkg * 8 + 4);
#pragma unroll
    for (int i = 0; i < 4; i++) { af[i] += k0[i] * vf; ab[i] += k0[i] * vb; af[4 + i] += k1[i] * vf; ab[4 + i] += k1[i] * vb; }
  }
  float* dS = (float*)(p.ws + OFF_DS);
  float* of = dS + ((size_t)(((b * 4 + h) * 2 + 0) * 130 + blk)) * 2048 + dv * 32 + dkg * 8;
  float* ob = dS + ((size_t)(((b * 4 + h) * 2 + 1) * 130 + blk)) * 2048 + dv * 32 + dkg * 8;
#pragma unroll
  for (int i = 0; i < 8; i++) { of[i] = af[i]; ob[i] = ab[i]; }
  __syncthreads();
}
__device__ __forceinline__ void retc2_item(const Params& p, int l, int item) {
  const int e = item * 256 + ltid();
  const int bhd = e >> 11, el = e & 2047;
  const int d = bhd & 1, h = (bhd >> 1) & 3;
  const float cdec = fexp2(128.f * ret_lg(p, l, d, h));
  const float* dS = (const float*)(p.ws + OFF_DS) + (size_t)bhd * 130 * 2048 + el;
  u16* Sin = (u16*)(p.ws + OFF_SIN) + (size_t)bhd * 130 * 2048 + el;
  float S = 0.f;
  for (int i0 = 0; i0 < 130; i0 += 13) {
    float dv[13];
#pragma unroll
    for (int u = 0; u < 13; u++) {
      const int i = i0 + u;
      const int blk = d == 0 ? i : (i == 0 ? 1 : (i == 1 ? 0 : 131 - i));
      dv[u] = dS[(size_t)blk * 2048];
    }
#pragma unroll
    for (int u = 0; u < 13; u++) {
      const int i = i0 + u;
      const int blk = d == 0 ? i : (i == 0 ? 1 : (i == 1 ? 0 : 131 - i));
      Sin[(size_t)blk * 2048] = f2bf(S);
      S = S * cdec + dv[u];
    }
  }
}
__device__ __forceinline__ void retc3_item(const Params& p, int l, int item, u16* sm) {
  const int tid = ltid(), lane = tid & 63, w = __builtin_amdgcn_readfirstlane(tid >> 6), r = lane & 31, hh = lane >> 5;
  const int h = item & 3, bb = item >> 2;
  const int b = bb / 130, blk = bb - b * 130;
  u16* ACD = (u16*)(p.ws + OFF_ACD);
  u16* Kt = sm;
  u16* Vt = sm + 128 * 40;
  const size_t row0 = (size_t)b * TT + blk * 128;
  const float lgf = ret_lg(p, l, 0, h), lgb = ret_lg(p, l, 1, h);
  const int iq = 32 * w + r;
  const size_t qrow = row0 + iq;
  u4 kst[2], vst[2][2], qraw[2], sfr[2][2][2];
  u2 graw[2][4];
#pragma unroll
  for (int i = 0; i < 2; i++) { const int cI = tid + 256 * i; kst[i] = *(const u4*)(ACD + (row0 + (cI >> 2)) * PACD + 896 + h * 32 + (cI & 3) * 8); }
#pragma unroll
  for (int i = 0; i < 2; i++) {
    const int u = tid + 256 * i, kp = u >> 3, dg = u & 7;
    vst[i][0] = *(const u4*)(ACD + (row0 + 2 * kp) * PACD + 1024 + h * 64 + dg * 8);
    vst[i][1] = *(const u4*)(ACD + (row0 + 2 * kp + 1) * PACD + 1024 + h * 64 + dg * 8);
  }
  qraw[0] = *(const u4*)(ACD + qrow * PACD + 768 + h * 32 + 8 * hh);
  qraw[1] = *(const u4*)(ACD + qrow * PACD + 768 + h * 32 + 16 + 8 * hh);
  {
    const u16* Sin = (const u16*)(p.ws + OFF_SIN);
#pragma unroll
    for (int d = 0; d < 2; d++)
#pragma unroll
      for (int s2 = 0; s2 < 2; s2++)
#pragma unroll
        for (int dt = 0; dt < 2; dt++)
          sfr[d][s2][dt] = *(const u4*)(Sin + ((size_t)(((b * 4 + h) * 2 + d) * 130 + blk)) * 2048 + (32 * dt + r) * 32 + 16 * s2 + 8 * hh);
  }
#pragma unroll
  for (int dt = 0; dt < 2; dt++)
#pragma unroll
    for (int i4 = 0; i4 < 4; i4++) graw[dt][i4] = *(const u2*)(ACD + qrow * PACD + 1280 + h * 64 + 32 * dt + 8 * i4 + 4 * hh);
#pragma unroll
  for (int i = 0; i < 2; i++) { const int cI = tid + 256 * i; *(u4*)(Kt + (cI >> 2) * 40 + (cI & 3) * 8) = kst[i]; }
#pragma unroll
  for (int i = 0; i < 2; i++) {
    const int u = tid + 256 * i, kp = u >> 3, dg = u & 7;
#pragma unroll
    for (int e = 0; e < 4; e++) {
      unsigned a = vst[i][0][e], c2 = vst[i][1][e];
      *(unsigned*)(Vt + (dg * 8 + 2 * e) * 136 + 2 * kp) = (a & 0xffffu) | (c2 << 16);
      *(unsigned*)(Vt + (dg * 8 + 2 * e + 1) * 136 + 2 * kp) = (a >> 16) | (c2 & 0xffff0000u);
    }
  }
  __syncthreads();
  f16 oacc[2];
#pragma unroll
  for (int i = 0; i < 16; i++) { oacc[0][i] = 0.f; oacc[1][i] = 0.f; }
#pragma unroll
  for (int kb = 0; kb < 4; kb++) {
    f16 st;
#pragma unroll
    for (int i = 0; i < 16; i++) st[i] = 0.f;
#pragma unroll
    for (int s = 0; s < 2; s++) {
      bf8 a = *(const bf8*)(Kt + (32 * kb + swz23(r)) * 40 + 16 * s + 8 * hh);
      st = __builtin_amdgcn_mfma_f32_32x32x16_bf16(a, __builtin_bit_cast(bf8, qraw[s]), st, 0, 0, 0);
    }
    u4 pb[2];
#pragma unroll
    for (int i = 0; i < 16; i++) {
      int key = 32 * kb + (i & 7) + 8 * hh + 16 * (i >> 3);
      int dd = iq - key;
      float wgt = dd > 0 ? fexp2((float)dd * lgf) : (dd < 0 ? fexp2((float)(-dd) * lgb) : 2.f);
      st[i] *= wgt;
    }
#pragma unroll
    for (int s = 0; s < 2; s++)
#pragma unroll
      for (int q = 0; q < 4; q++) pb[s][q] = pk2(st[8 * s + 2 * q], st[8 * s + 2 * q + 1]);
#pragma unroll
    for (int dt = 0; dt < 2; dt++)
#pragma unroll
      for (int s = 0; s < 2; s++) {
        bf8 a = *(const bf8*)(Vt + (32 * dt + r) * 136 + 32 * kb + 16 * s + 8 * hh);
        oacc[dt] = __builtin_amdgcn_mfma_f32_32x32x16_bf16(a, __builtin_bit_cast(bf8, pb[s]), oacc[dt], 0, 0, 0);
      }
  }
  {
    const float qdf = fexp2((float)(iq + 1) * lgf), qdb = fexp2((float)(128 - iq) * lgb);
#pragma unroll
    for (int d = 0; d < 2; d++) {
      const float qd = d == 0 ? qdf : qdb;
#pragma unroll
      for (int s = 0; s < 2; s++) {
        u4 qs;
#pragma unroll
        for (int q = 0; q < 4; q++) qs[q] = pk2(lo16(qraw[s][q]) * qd, hi16(qraw[s][q]) * qd);
#pragma unroll
        for (int dt = 0; dt < 2; dt++) {
          oacc[dt] = __builtin_amdgcn_mfma_f32_32x32x16_bf16(__builtin_bit_cast(bf8, sfr[d][s][dt]), __builtin_bit_cast(bf8, qs), oacc[dt], 0, 0, 0);
        }
      }
    }
  }
  float sum = 0.f;
#pragma unroll
  for (int dt = 0; dt < 2; dt++)
#pragma unroll
    for (int i = 0; i < 16; i++) sum += oacc[dt][i];
  sum = xhalf_sum(sum);
  const float mean = sum * (1.f / 64.f);
  float var = 0.f;
#pragma unroll
  for (int dt = 0; dt < 2; dt++)
#pragma unroll
    for (int i = 0; i < 16; i++) { float dlt = oacc[dt][i] - mean; var += dlt * dlt; }
  var = xhalf_sum(var) * (1.f / 64.f);
  const float rstd = rsqrtf(var + 1e-5f);
  const float* gn = p.ret_gn + l * 256 + h * 64;
#pragma unroll
  for (int dt = 0; dt < 2; dt++)
#pragma unroll
    for (int i4 = 0; i4 < 4; i4++) {
      const int dv = 32 * dt + 8 * i4 + 4 * hh;
      u16* gp = ACD + qrow * PACD + 1280 + h * 64 + dv;
      const u2 gr = graw[dt][i4];
      float g[4] = {lo16(gr[0]), hi16(gr[0]), lo16(gr[1]), hi16(gr[1])};
      float o[4];
#pragma unroll
      for (int q = 0; q < 4; q++) {
        float y = (oacc[dt][4 * i4 + q] - mean) * rstd * gn[dv + q];
        o[q] = y * g[q] * fsigmoid(g[q]);
      }
      u2 ov; ov[0] = pk2(o[0], o[1]); ov[1] = pk2(o[2], o[3]);
      *(u2*)gp = ov;
    }
  __syncthreads();
}

constexpr int SLOT = 64 * LDT;
constexpr int MABS = 68;
__device__ __forceinline__ int rw_row(int d, int b, int i) {
  int t = d == 0 ? i : (i < CTX ? CTX - 1 - i : TT + CTX - 1 - i);
  return b * TT + t;
}
template <bool PERM>
__device__ __forceinline__ void mm64(f16& acc, const u16* A, const u16* B, int tm, int tn, int r, int hh) {
  const int ar = PERM ? swz23(r) : r;
#pragma unroll
  for (int s = 0; s < 4; s++) {
    bf8 a = *(const bf8*)(A + (32 * tm + ar) * LDT + 16 * s + 8 * hh);
    bf8 bb = *(const bf8*)(B + (32 * tn + r) * LDT + 16 * s + 8 * hh);
    acc = __builtin_amdgcn_mfma_f32_32x32x16_bf16(a, bb, acc, 0, 0, 0);
  }
}
__device__ __forceinline__ void zero16(f16& a) {
#pragma unroll
  for (int i = 0; i < 16; i++) a[i] = 0.f;
}
template <int MASK>
__device__ __forceinline__ void put_tile(u16* dst, const f16& acc, int tm, int tn, int r, int hh) {
#pragma unroll
  for (int i = 0; i < 16; i++) {
    int row = 32 * tm + (i & 3) + 8 * (i >> 2) + 4 * hh, col = 32 * tn + r;
    float v = acc[i];
    if (MASK == 1 && !(row > col)) v = 0.f;
    if (MASK == 2 && !(row >= col)) v = 0.f;
    dst[row * LDT + col] = f2bf(v);
  }
}
template <int MASK>
__device__ __forceinline__ void put_tile_T(u16* dst, const f16& acc, int tm, int tn, int r, int hh) {
#pragma unroll
  for (int i4 = 0; i4 < 4; i4++) {
    const int row0 = 32 * tm + 8 * i4 + 4 * hh, col = 32 * tn + r;
    float v[4];
#pragma unroll
    for (int q = 0; q < 4; q++) {
      v[q] = acc[4 * i4 + q];
      if (MASK == 3 && !(((row0 + q) >> 4) > (col >> 4))) v[q] = 0.f;
    }
    u2 o; o[0] = pk2(v[0], v[1]); o[1] = pk2(v[2], v[3]);
    *(u2*)(dst + col * LDT + row0) = o;
  }
}

template <int MODE>
__device__ __forceinline__ void rwkv_chunk(const Params& p, int b, int h, int d, int c, u16* sm, f16& yout) {
  const int tid = ltid(), lane = tid & 63, w = __builtin_amdgcn_readfirstlane(tid >> 6), r = lane & 31, hh = lane >> 5;
  const int tm = w >> 1, tn = w & 1;
  u16 *x0 = sm, *x1 = sm + SLOT, *x2 = sm + 2 * SLOT, *x3 = sm + 3 * SLOT, *x4 = sm + 4 * SLOT, *x5 = sm + 5 * SLOT,
      *x6 = sm + 6 * SLOT, *x7 = sm + 7 * SLOT;
  float* dg = (float*)(sm + 8 * SLOT);
  float* qs = dg + 1024;
  float* wc = qs + 256;
  u16* AHT = MODE == 0 ? x6 : x5;
  u16* LTN = MODE == 0 ? x7 : x6;
  u16* TD = MODE == 0 ? x2 : x1;
  const u16* scan = (const u16*)(p.ws + OFF_SCAN);
  unsigned char* cbase = p.ws + OFF_CB + ((size_t)(((b * 4 + h) * 2 + d) * 260 + c)) * 16384;
  {
    const int k = lane, q = w, col = h * 64 + k;
    float lam[16], run = 0.f;
#pragma unroll
    for (int u = 0; u < 16; u++) {
      size_t ro = (size_t)rw_row(d, b, 64 * c + 16 * q + u) * 256 + col;
      lam[u] = bf2f(scan[(size_t)(3 + 3 * d) * ARR + ro]);
      run += lam[u];
    }
    u16 rkk[16], rbb[16], rkd[16], rvv[16], rrr[16];
#pragma unroll
    for (int u = 0; u < 16; u++) {
      size_t ro = (size_t)rw_row(d, b, 64 * c + 16 * q + u) * 256 + col;
      rkk[u] = scan[2 * ARR + ro];
      rbb[u] = scan[(size_t)(5 + 3 * d) * ARR + ro];
      rkd[u] = scan[(size_t)(4 + 3 * d) * ARR + ro];
      rvv[u] = scan[1 * ARR + ro];
      rrr[u] = MODE == 1 ? scan[0 * ARR + ro] : (u16)0;
    }
    qs[q * 64 + k] = run;
    __syncthreads();
    float pre = 0.f, tot = 0.f;
#pragma unroll
    for (int qq = 0; qq < 4; qq++) { float x = qs[qq * 64 + k]; tot += x; if (qq < q) pre += x; }
    float L = pre;
#pragma unroll
    for (int u = 0; u < 16; u++) {
      const int tau = 16 * q + u;
      const float Lp = L;
      L += lam[u];
      const float kk = bf2f(rkk[u]), bb = bf2f(rbb[u]);
      const float kd = bf2f(rkd[u]);
      const u16 vraw = rvv[u];
      const float eL = fexp2(L);
      const u16 ah = f2bf(kk * fexp2(-Lp));
      x0[tau * LDT + k] = ah;
      AHT[k * LDT + tau] = ah;
      x1[tau * LDT + k] = f2bf(bb * eL);
      x2[tau * LDT + k] = f2bf(kd * eL);
      x3[k * LDT + tau] = vraw;
      if (MODE == 0) {
        const float eC = fexp2(L - tot);
        x4[k * LDT + tau] = f2bf(bb * eC);
        x5[k * LDT + tau] = f2bf(kd * eC);
      } else {
        const float rr = bf2f(rrr[u]);
        x4[tau * LDT + k] = f2bf(rr * fexp2(-L));
      }
    }
    if (MODE == 0 && q == 0) wc[k] = fexp2(-tot);
    __syncthreads();
  }
  {
    f16 a_ab, a_ak, a_rb, a_rk;
    zero16(a_ab); zero16(a_ak); zero16(a_rb); zero16(a_rk);
    mm64<false>(a_ab, x0, x1, tm, tn, r, hh);
    mm64<false>(a_ak, x0, x2, tm, tn, r, hh);
    if (MODE == 1) {
      mm64<false>(a_rb, x4, x1, tm, tn, r, hh);
      mm64<false>(a_rk, x4, x2, tm, tn, r, hh);
    }
    __syncthreads();
#pragma unroll
    for (int i = 0; i < 16; i++) {
      int row = 32 * tm + (i & 3) + 8 * (i >> 2) + 4 * hh, col = 32 * tn + r;
      if ((row >> 4) == (col >> 4)) dg[(row >> 4) * 256 + (row & 15) * 16 + (col & 15)] = row > col ? a_ab[i] : 0.f;
    }
    put_tile_T<3>(LTN, a_ab, tm, tn, r, hh);
    put_tile<1>(x1, a_ak, tm, tn, r, hh);
    if (MODE == 1) { put_tile<2>(x2, a_rb, tm, tn, r, hh); put_tile<2>(x7, a_rk, tm, tn, r, hh); }
    __syncthreads();
  }
  {
    f16 a;
    zero16(a);
    mm64<false>(a, x1, x3, tm, tn, r, hh);
    float X[16];
    const int cc = lane & 15, gq = lane >> 4;
#pragma unroll
    for (int t = 0; t < 16; t++) {
      float acc = t == cc ? 1.f : 0.f;
#pragma unroll
      for (int j = 0; j < t; j++) acc -= dg[w * 256 + t * 16 + j] * X[j];
      X[t] = acc;
    }
    __syncthreads();
    put_tile_T<0>(x0, a, tm, tn, r, hh);
#pragma unroll
    for (int t = 0; t < 16; t++) TD[(16 * w + t) * LDT + 16 * gq + cc] = f2bf(gq == w ? X[t] : 0.f);
    __syncthreads();
  }
  {
    f16 n;
    zero16(n);
    mm64<false>(n, TD, LTN, tm, tn, r, hh);
    __syncthreads();
    put_tile<0>(LTN, n, tm, tn, r, hh);
    __syncthreads();
  }
  {
    f16 z0p, z0q;
    zero16(z0p); zero16(z0q);
    mm64<false>(z0p, TD, AHT, tm, tn, r, hh);
    mm64<false>(z0q, TD, x0, tm, tn, r, hh);
    __syncthreads();
    put_tile_T<0>(AHT, z0p, tm, tn, r, hh);
    put_tile_T<0>(x0, z0q, tm, tn, r, hh);
    __syncthreads();
#pragma unroll 1
    for (int itn = 0; itn < 3; itn++) {
      f16 np_, nq_;
      zero16(np_); zero16(nq_);
      mm64<false>(np_, LTN, AHT, tm, tn, r, hh);
      mm64<false>(nq_, LTN, x0, tm, tn, r, hh);
#pragma unroll
      for (int i = 0; i < 16; i++) { np_[i] = z0p[i] - np_[i]; nq_[i] = z0q[i] - nq_[i]; }
      __syncthreads();
      put_tile_T<0>(AHT, np_, tm, tn, r, hh);
      put_tile_T<0>(x0, nq_, tm, tn, r, hh);
      __syncthreads();
    }
  }
  if (MODE == 0) {
    f16 g;
    zero16(g);
    mm64<false>(g, x4, AHT, tm, tn, r, hh);
    u16* GT = (u16*)cbase;
#pragma unroll
    for (int i = 0; i < 16; i++) {
      int row = 32 * tm + (i & 3) + 8 * (i >> 2) + 4 * hh, col = 32 * tn + r;
      float v = (row == col ? wc[row] : 0.f) - g[i];
      GT[row * 64 + col] = f2bf(v);
    }
    f16 h1, h2;
    zero16(h1); zero16(h2);
    mm64<true>(h1, x5, x3, tm, tn, r, hh);
    mm64<true>(h2, x4, x0, tm, tn, r, hh);
    unsigned* HM = (unsigned*)(cbase + 8192) + (tm * 2 + tn) * 512;
#pragma unroll
    for (int q = 0; q < 8; q++) HM[q * 64 + lane] = pk2(h1[2 * q] - h2[2 * q], h1[2 * q + 1] - h2[2 * q + 1]);
    __syncthreads();
  } else {
    f16 ry, y1, y2;
    zero16(ry); zero16(y1); zero16(y2);
    mm64<false>(ry, x2, AHT, tm, tn, r, hh);
    mm64<false>(y1, x7, x3, tm, tn, r, hh);
    mm64<false>(y2, x2, x0, tm, tn, r, hh);
#pragma unroll
    for (int i = 0; i < 16; i++) {
      int row = 32 * tm + (i & 3) + 8 * (i >> 2) + 4 * hh, col = 32 * tn + r;
      x4[row * LDT + col] = f2bf(bf2f(x4[row * LDT + col]) - ry[i]);
      y1[i] -= y2[i];
    }
    __syncthreads();
    const unsigned char* S0 = cbase + 8192;
#pragma unroll
    for (int s = 0; s < 4; s++) {
      bf8 a = *(const bf8*)(x4 + (32 * tm + r) * LDT + 16 * s + 8 * hh);
      u4 bq = *(const u4*)(S0 + ((s >> 1) * 2 + tn) * 2048 + (s & 1) * 1024 + lane * 16);
      y1 = __builtin_amdgcn_mfma_f32_32x32x16_bf16(a, __builtin_bit_cast(bf8, bq), y1, 0, 0, 0);
    }
    yout = y1;
    __syncthreads();
  }
}

__device__ __forceinline__ void rwkv_s1_item(const Params& p, int item, u16* sm) {
  const int c = item % 260, chain = item / 260;
  f16 dummy;
  rwkv_chunk<0>(p, chain >> 3, (chain >> 1) & 3, chain & 1, c, sm, dummy);
}

__device__ __forceinline__ void rwkv_s2_item(const Params& p, int item) {
  const int tid = ltid(), lane = tid & 63, w = __builtin_amdgcn_readfirstlane(tid >> 6), r = lane & 31, hh = lane >> 5;
  const int chain = item * 2 + (w >> 1), vt = w & 1;
  unsigned char* base = p.ws + OFF_CB + (size_t)chain * 260 * 16384;
  f16 acc[2];
  zero16(acc[0]); zero16(acc[1]);
  u4 g[2][4]; unsigned hm[2][8];
  const int goff = (swz23(r) * 64 + 8 * hh) * 2;
#pragma unroll
  for (int kt = 0; kt < 2; kt++) {
#pragma unroll
    for (int s = 0; s < 4; s++) g[kt][s] = *(const u4*)(base + goff + kt * 32 * 128 + s * 32);
#pragma unroll
    for (int q = 0; q < 8; q++) hm[kt][q] = *(const unsigned*)(base + 8192 + (((kt * 2 + vt) * 8 + q) * 64 + lane) * 4);
  }
  for (int c = 0; c < 260; c++) {
    u4 gn[2][4]; unsigned hn[2][8];
    unsigned char* cb = base + (size_t)c * 16384;
    {
      const unsigned char* nb = base + (size_t)(c + 1 < 260 ? c + 1 : c) * 16384;
#pragma unroll
      for (int kt = 0; kt < 2; kt++) {
#pragma unroll
        for (int s = 0; s < 4; s++) gn[kt][s] = *(const u4*)(nb + goff + kt * 32 * 128 + s * 32);
#pragma unroll
        for (int q = 0; q < 8; q++) hn[kt][q] = *(const unsigned*)(nb + 8192 + (((kt * 2 + vt) * 8 + q) * 64 + lane) * 4);
      }
    }
    u4 bfg[4];
#pragma unroll
    for (int kt = 0; kt < 2; kt++)
#pragma unroll
      for (int s2 = 0; s2 < 2; s2++)
#pragma unroll
        for (int q = 0; q < 4; q++) bfg[2 * kt + s2][q] = pk2(acc[kt][8 * s2 + 2 * q], acc[kt][8 * s2 + 2 * q + 1]);
#pragma unroll
    for (int s = 0; s < 4; s++) *(u4*)(cb + 8192 + ((s >> 1) * 2 + vt) * 2048 + (s & 1) * 1024 + lane * 16) = bfg[s];
#pragma unroll
    for (int kt = 0; kt < 2; kt++) {
      f16 a;
#pragma unroll
      for (int q = 0; q < 8; q++) { a[2 * q] = lo16(hm[kt][q]); a[2 * q + 1] = hi16(hm[kt][q]); }
#pragma unroll
      for (int s = 0; s < 4; s++)
        a = __builtin_amdgcn_mfma_f32_32x32x16_bf16(__builtin_bit_cast(bf8, g[kt][s]), __builtin_bit_cast(bf8, bfg[s]), a, 0, 0, 0);
      acc[kt] = a;
    }
#pragma unroll
    for (int kt = 0; kt < 2; kt++) {
#pragma unroll
      for (int s = 0; s < 4; s++) g[kt][s] = gn[kt][s];
#pragma unroll
      for (int q = 0; q < 8; q++) hm[kt][q] = hn[kt][q];
    }
  }
}

__device__ __forceinline__ float qsum(float x) {
  x += __builtin_bit_cast(float, __builtin_amdgcn_update_dpp(0, __builtin_bit_cast(int, x), 0xB1, 0xF, 0xF, true));
  x += __builtin_bit_cast(float, __builtin_amdgcn_update_dpp(0, __builtin_bit_cast(int, x), 0x4E, 0xF, 0xF, true));
  return x;
}
__device__ __forceinline__ void rwkv_s3_item(const Params& p, int l, int item, u16* sm) {
  const int tid = ltid(), lane = tid & 63, w = __builtin_amdgcn_readfirstlane(tid >> 6), r = lane & 31, hh = lane >> 5;
  const int tm = w >> 1, tn = w & 1;
  const int tc = item % 260, bh = item / 260, b = bh >> 2, h = bh & 3;
  f16 yf, yb;
  zero16(yf); zero16(yb);
  for (int d = 0; d < 2; d++) {
    const int c = d == 0 ? tc : (tc < 4 ? 3 - tc : 263 - tc);
    f16 y;
    rwkv_chunk<1>(p, b, h, d, c, sm, y);
    if (d == 0) yf = y; else yb = y;
  }
  float* Ys = (float*)sm;
#pragma unroll
  for (int i = 0; i < 16; i++) {
    int row = 32 * tm + (i & 3) + 8 * (i >> 2) + 4 * hh;
    Ys[row * MABS + 32 * tn + r] = yf[i];
  }
  __syncthreads();
#pragma unroll
  for (int i = 0; i < 16; i++) {
    int row = 63 - (32 * tm + (i & 3) + 8 * (i >> 2) + 4 * hh);
    Ys[row * MABS + 32 * tn + r] += yb[i];
  }
  __syncthreads();
  {
    const int tok = tid >> 2, q4 = tid & 3;
    const size_t ro = (size_t)(b * TT + 64 * tc + tok) * 256 + h * 64 + 16 * q4;
    const u16* scan = (const u16*)(p.ws + OFF_SCAN);
    u16* GB = (u16*)(p.ws + OFF_GB);
    float y[16], sum = 0.f, sq = 0.f;
#pragma unroll
    for (int i = 0; i < 4; i++) {
      f4 v4 = *(const f4*)(Ys + tok * MABS + 16 * q4 + 4 * i);
#pragma unroll
      for (int j = 0; j < 4; j++) { y[4 * i + j] = v4[j]; sum += v4[j]; sq += v4[j] * v4[j]; }
    }
    sum = qsum(sum); sq = qsum(sq);
    const float mean = sum * (1.f / 64.f);
    const float var = fmaxf(sq * (1.f / 64.f) - mean * mean, 0.f);
    const float rstd = rsqrtf(var + 64e-5f);
    float rr[16], kf[16], kb[16], vv[16], gg[16];
    auto ld16 = [&](const u16* src, float* dst) {
      u4 a = *(const u4*)src, c2 = *(const u4*)(src + 8);
#pragma unroll
      for (int e = 0; e < 4; e++) { dst[2 * e] = lo16(a[e]); dst[2 * e + 1] = hi16(a[e]); dst[8 + 2 * e] = lo16(c2[e]); dst[8 + 2 * e + 1] = hi16(c2[e]); }
    };
    ld16(scan + 0 * ARR + ro, rr); ld16(scan + 4 * ARR + ro, kf); ld16(scan + 7 * ARR + ro, kb);
    ld16(scan + 1 * ARR + ro, vv); ld16(GB + ro, gg);
    const float* rk = p.rrk + l * 256 + h * 64 + 16 * q4;
    const float* lg = p.lnx_g + l * 256 + h * 64 + 16 * q4;
    const float* lb = p.lnx_b + l * 256 + h * 64 + 16 * q4;
    float bonus = 0.f;
#pragma unroll
    for (int i = 0; i < 16; i++) bonus += rr[i] * (kf[i] + kb[i]) * rk[i];
    bonus = qsum(bonus);
    float o[16];
#pragma unroll
    for (int i = 0; i < 16; i++) o[i] = ((y[i] - mean) * rstd * lg[i] + lb[i] + bonus * vv[i]) * gg[i];
    store8(GB + ro, o);
    store8(GB + ro + 8, o + 8);
  }
  __syncthreads();
}

template <int MODE>
__device__ __forceinline__ void attn_item(const Params& p, int l, int item, u16* sm) {
  constexpr int NS = MODE == 0 ? 2 : 4;
  const int tid = ltid(), lane = tid & 63, w = __builtin_amdgcn_readfirstlane(tid >> 6), r = lane & 31, hh = lane >> 5;
  const int pl = w >> 1, rb = w & 1;
  u16* ACD = (u16*)(p.ws + OFF_ACD);
  int b, hd, qrow0, ntile, jlo = 0, qb = 0;
  bool latent;
  if (MODE == 0) {
    if (item < 2048) { b = item >> 10; hd = (item >> 8) & 3; qb = item & 255; qrow0 = b * TT + CTX + 64 * qb; ntile = 260; latent = true; }
    else { int j = item - 2048; b = j >> 4; hd = (j >> 2) & 3; qrow0 = b * TT + 64 * (j & 3); ntile = 4; latent = false; }
  } else {
    if (item < 1024) {
      b = item >> 9; hd = (item >> 8) & 1; qb = item & 255; qrow0 = b * TT + CTX + 64 * qb; latent = true;
      jlo = qb - 2; if (jlo < 0) jlo = 0;
      int jhi = qb + 3; if (jhi > 256) jhi = 256;
      ntile = 4 + (jhi - jlo);
    } else { int j = item - 1024; b = j >> 3; hd = (j >> 2) & 1; qrow0 = b * TT + 64 * (j & 3); ntile = 4; latent = false; }
  }
  const int kcol = MODE == 0 ? 256 + hd * 64 : 1792 + hd * 64;
  const int vcol = MODE == 0 ? 512 + hd * 64 : 1920 + hd * 64;
  const int qcol = MODE == 0 ? hd * 64 + 32 * pl : 1536 + hd * 128 + 64 * pl;
  const int koff = MODE == 0 ? 32 * pl : 0;
  const size_t qrow = (size_t)qrow0 + 32 * rb + r;
  bf8 qf[NS];
#pragma unroll
  for (int s = 0; s < NS; s++) qf[s] = *(const bf8*)(ACD + qrow * PACD + qcol + 16 * s + 8 * hh);
  f16 O[2], negm, lacc;
  float m = 0.f;
#pragma unroll
  for (int i = 0; i < 16; i++) { O[0][i] = 0.f; O[1][i] = 0.f; negm[i] = 0.f; lacc[i] = 0.f; }
  u4 ones_u; ones_u[0] = ones_u[1] = ones_u[2] = ones_u[3] = 0x3F803F80u;
  const bf8 ones = __builtin_bit_cast(bf8, ones_u);
  auto keyrow0 = [&](int kt) -> size_t {
    if (MODE == 0 || kt < 4) return (size_t)b * TT + 64 * kt;
    return (size_t)b * TT + CTX + 64 * (jlo + kt - 4);
  };
  u4 rkA[2], rvA[2], rkB[2], rvB[2];
  const int kr = tid >> 3, kc = (tid & 7) * 8;
  const int kp = tid >> 3, dg = tid & 7;
  auto gload = [&](u4 (&rk)[2], u4 (&rv)[2], int kt) {
    const size_t k0 = keyrow0(kt);
    rk[0] = *(const u4*)(ACD + (k0 + kr) * PACD + kcol + kc);
    rk[1] = *(const u4*)(ACD + (k0 + kr + 32) * PACD + kcol + kc);
    rv[0] = *(const u4*)(ACD + (k0 + 2 * kp) * PACD + vcol + dg * 8);
    rv[1] = *(const u4*)(ACD + (k0 + 2 * kp + 1) * PACD + vcol + dg * 8);
  };
  auto swrite = [&](const u4 (&rk)[2], const u4 (&rv)[2], int buf) {
    u16* Kb = sm + buf * 2 * 64 * LDT;
    u16* Vb = Kb + 64 * LDT;
    *(u4*)(Kb + kr * LDT + kc) = rk[0];
    *(u4*)(Kb + (kr + 32) * LDT + kc) = rk[1];
#pragma unroll
    for (int e = 0; e < 4; e++) {
      unsigned a = rv[0][e], c2 = rv[1][e];
      *(unsigned*)(Vb + (dg * 8 + 2 * e) * LDT + 2 * kp) = (a & 0xffffu) | (c2 << 16);
      *(unsigned*)(Vb + (dg * 8 + 2 * e + 1) * LDT + 2 * kp) = (a >> 16) | (c2 & 0xffff0000u);
    }
  };
  gload(rkA, rvA, 0);
  gload(rkB, rvB, 1);
  swrite(rkA, rvA, 0);
  __syncthreads();
  const int qlo = 64 * qb + 32 * rb;
  const int qpos = qlo + r;
  auto tile_body = [&](int kt, u4 (&rkL)[2], u4 (&rvL)[2], u4 (&rkW)[2], u4 (&rvW)[2]) {
    if (kt + 2 < ntile) gload(rkL, rvL, kt + 2);
    const u16* Kb = sm + (kt & 1) * 2 * 64 * LDT;
    const u16* Vb = Kb + 64 * LDT;
    bool skip = false;
    int kpos0 = 0;
    const bool masked = (MODE == 1) && latent && kt >= 4;
    if (masked) {
      kpos0 = 64 * (jlo + kt - 4);
      if (kpos0 > qlo + 31 + 128 || kpos0 + 63 < qlo - 128) skip = true;
    }
    if (!skip) {
      u4 pb[2][2];
      f16 st[2];
#pragma unroll
      for (int kb = 0; kb < 2; kb++) {
        st[kb] = negm;
#pragma unroll
        for (int s = 0; s < NS; s++) {
          bf8 a = *(const bf8*)(Kb + (32 * kb + swz23(r)) * LDT + koff + 16 * s + 8 * hh);
          st[kb] = __builtin_amdgcn_mfma_f32_32x32x16_bf16(a, qf[s], st[kb], 0, 0, 0);
        }
      }
      if (masked) {
#pragma unroll
        for (int kb = 0; kb < 2; kb++)
#pragma unroll
          for (int i = 0; i < 16; i++) {
            int kpos = kpos0 + 32 * kb + (i & 7) + 8 * hh + 16 * (i >> 3);
            int dd = qpos - kpos;
            if (dd > 128 || dd < -128) st[kb][i] = -1e30f;
          }
      }
      float mt = st[0][0];
#pragma unroll
      for (int i = 1; i < 16; i++) mt = fmaxf(mt, st[0][i]);
#pragma unroll
      for (int i = 0; i < 16; i++) mt = fmaxf(mt, st[1][i]);
      mt = xhalf_max(mt);
      const bool first = kt == 0;
      if (first || __any(mt > 8.f)) {
        const float dm = first ? mt : fmaxf(mt, 0.f);
        const float al = first ? 1.f : fexp2(-dm);
        m += dm;
        lacc[0] *= al;
#pragma unroll
        for (int i = 0; i < 16; i++) { O[0][i] *= al; O[1][i] *= al; st[0][i] -= dm; st[1][i] -= dm; negm[i] = -m; }
      }
#pragma unroll
      for (int kb = 0; kb < 2; kb++) {
#pragma unroll
        for (int i = 0; i < 16; i++) st[kb][i] = fexp2(st[kb][i]);
#pragma unroll
        for (int s = 0; s < 2; s++)
#pragma unroll
          for (int q = 0; q < 4; q++) pb[kb][s][q] = pk2(st[kb][8 * s + 2 * q], st[kb][8 * s + 2 * q + 1]);
      }
#pragma unroll
      for (int kb = 0; kb < 2; kb++)
#pragma unroll
        for (int s = 0; s < 2; s++)
          lacc = __builtin_amdgcn_mfma_f32_32x32x16_bf16(ones, __builtin_bit_cast(bf8, pb[kb][s]), lacc, 0, 0, 0);
#pragma unroll
      for (int dt = 0; dt < 2; dt++)
#pragma unroll
        for (int kb = 0; kb < 2; kb++)
#pragma unroll
          for (int s = 0; s < 2; s++) {
            bf8 a = *(const bf8*)(Vb + (32 * dt + r) * LDT + 32 * kb + 16 * s + 8 * hh);
            O[dt] = __builtin_amdgcn_mfma_f32_32x32x16_bf16(a, __builtin_bit_cast(bf8, pb[kb][s]), O[dt], 0, 0, 0);
          }
    }
    if (kt + 1 < ntile) swrite(rkW, rvW, (kt + 1) & 1);
    __syncthreads();
  };
  for (int kt = 0; kt < ntile; kt += 2) {
    tile_body(kt, rkA, rvA, rkB, rvB);
    if (kt + 1 < ntile) tile_body(kt + 1, rkB, rvB, rkA, rvA);
  }
  if (MODE == 0) {
    const float lam_init = 0.8f - 0.6f * __expf(-0.3f * (float)l);
    float d0 = 0.f, d1 = 0.f;
    for (int i = 0; i < 32; i++) {
      d0 += p.lam_q[(l * 2 + 0) * 32 + i] * p.lam_k[(l * 2 + 0) * 32 + i];
      d1 += p.lam_q[(l * 2 + 1) * 32 + i] * p.lam_k[(l * 2 + 1) * 32 + i];
    }
    const float lam = __expf(d0) - __expf(d1) + lam_init;
    const float inv = (pl == 0 ? 1.f : lam) / lacc[0];
    float* xch = (float*)sm + rb * (32 * 64);
    if (pl == 1) {
#pragma unroll
      for (int dt = 0; dt < 2; dt++)
#pragma unroll
        for (int i = 0; i < 16; i++) xch[(dt * 16 + i) * 64 + lane] = O[dt][i] * inv;
    }
    __syncthreads();
    if (pl == 0) {
      float ss = 0.f;
#pragma unroll
      for (int dt = 0; dt < 2; dt++)
#pragma unroll
        for (int i = 0; i < 16; i++) { float o = O[dt][i] * inv - xch[(dt * 16 + i) * 64 + lane]; O[dt][i] = o; ss += o * o; }
      ss = xhalf_sum(ss);
      const float rs = rsqrtf(ss * (1.f / 64.f) + 1e-5f) * (1.f - lam_init);
      const float* gs = p.subln + l * 256 + hd * 64;
#pragma unroll
      for (int dt = 0; dt < 2; dt++)
#pragma unroll
        for (int i4 = 0; i4 < 4; i4++) {
          const int dv = 32 * dt + 8 * i4 + 4 * hh;
          u2 ov;
          ov[0] = pk2(O[dt][4 * i4 + 0] * rs * gs[dv + 0], O[dt][4 * i4 + 1] * rs * gs[dv + 1]);
          ov[1] = pk2(O[dt][4 * i4 + 2] * rs * gs[dv + 2], O[dt][4 * i4 + 3] * rs * gs[dv + 3]);
          *(u2*)(ACD + qrow * PACD + hd * 64 + dv) = ov;
        }
    }
    __syncthreads();
  } else {
    const float sk = p.win_sink[l * 4 + hd * 2 + pl] * LOG2E;
    const float lt = lacc[0] + fexp2(sk - m);
    const float inv = 1.f / lt;
#pragma unroll
    for (int dt = 0; dt < 2; dt++)
#pragma unroll
      for (int i4 = 0; i4 < 4; i4++) {
        const int dv = 32 * dt + 8 * i4 + 4 * hh;
        u2 ov;
        ov[0] = pk2(O[dt][4 * i4 + 0] * inv, O[dt][4 * i4 + 1] * inv);
        ov[1] = pk2(O[dt][4 * i4 + 2] * inv, O[dt][4 * i4 + 3] * inv);
        *(u2*)(ACD + qrow * PACD + 1536 + (hd * 2 + pl) * 64 + dv) = ov;
      }
  }
}

__device__ __forceinline__ void attnA2_item(const Params& p, int l, int item, u16* sm) {
  const int tid = ltid(), lane = tid & 63, w = __builtin_amdgcn_readfirstlane(tid >> 6), r = lane & 31, hh = lane >> 5;
  u16* ACD = (u16*)(p.ws + OFF_ACD);
  int b, hd, qrow0, ntile;
  if (item < 1024) { b = item >> 9; hd = (item >> 7) & 3; qrow0 = b * TT + CTX + 128 * (item & 127); ntile = 260; }
  else { int j = item - 1024; b = j >> 3; hd = (j >> 1) & 3; qrow0 = b * TT + 128 * (j & 1); ntile = 4; }
  const int kcol = 256 + hd * 64, vcol = 512 + hd * 64;
  const size_t qrow = (size_t)qrow0 + 32 * w + r;
  bf8 qf[2][2];
#pragma unroll
  for (int pl = 0; pl < 2; pl++)
#pragma unroll
    for (int s = 0; s < 2; s++) qf[pl][s] = *(const bf8*)(ACD + qrow * PACD + hd * 64 + 32 * pl + 16 * s + 8 * hh);
  f16 O[2][2];
  float m[2] = {0.f, 0.f}, lsum[2] = {0.f, 0.f};
#pragma unroll
  for (int pl = 0; pl < 2; pl++)
#pragma unroll
    for (int dt = 0; dt < 2; dt++)
#pragma unroll
      for (int i = 0; i < 16; i++) O[pl][dt][i] = 0.f;
  u4 rkA[2], rvA[2], rkB[2], rvB[2];
  const int kr = tid >> 3, kc = (tid & 7) * 8;
  const int kp = tid >> 3, dg = tid & 7;
  auto gload = [&](u4 (&rk)[2], u4 (&rv)[2], int kt) {
    const size_t k0 = (size_t)b * TT + 64 * kt;
    rk[0] = *(const u4*)(ACD + (k0 + kr) * PACD + kcol + kc);
    rk[1] = *(const u4*)(ACD + (k0 + kr + 32) * PACD + kcol + kc);
    rv[0] = *(const u4*)(ACD + (k0 + 2 * kp) * PACD + vcol + dg * 8);
    rv[1] = *(const u4*)(ACD + (k0 + 2 * kp + 1) * PACD + vcol + dg * 8);
  };
  auto swrite = [&](const u4 (&rk)[2], const u4 (&rv)[2], int buf) {
    u16* Kb = sm + buf * 2 * 64 * LDT;
    u16* Vb = Kb + 64 * LDT;
    *(u4*)(Kb + kr * LDT + kc) = rk[0];
    *(u4*)(Kb + (kr + 32) * LDT + kc) = rk[1];
#pragma unroll
    for (int e = 0; e < 4; e++) {
      unsigned a = rv[0][e], c2 = rv[1][e];
      *(unsigned*)(Vb + (dg * 8 + 2 * e) * LDT + 2 * kp) = (a & 0xffffu) | (c2 << 16);
      *(unsigned*)(Vb + (dg * 8 + 2 * e + 1) * LDT + 2 * kp) = (a >> 16) | (c2 & 0xffff0000u);
    }
  };
  gload(rkA, rvA, 0);
  gload(rkB, rvB, 1);
  swrite(rkA, rvA, 0);
  __syncthreads();
  auto tile_body = [&](int kt, u4 (&rkL)[2], u4 (&rvL)[2], u4 (&rkW)[2], u4 (&rvW)[2]) {
    if (kt + 2 < ntile) gload(rkL, rvL, kt + 2);
    const u16* Kb = sm + (kt & 1) * 2 * 64 * LDT;
    const u16* Vb = Kb + 64 * LDT;
    const bool first = kt == 0;
#pragma unroll
    for (int pl = 0; pl < 2; pl++) {
      u4 pb[2][2];
      f16 st[2];
#pragma unroll
      for (int kb = 0; kb < 2; kb++) {
#pragma unroll
        for (int i = 0; i < 16; i++) st[kb][i] = 0.f;
#pragma unroll
        for (int s = 0; s < 2; s++) {
          bf8 a = *(const bf8*)(Kb + (32 * kb + swz23(r)) * LDT + 32 * pl + 16 * s + 8 * hh);
          st[kb] = __builtin_amdgcn_mfma_f32_32x32x16_bf16(a, qf[pl][s], st[kb], 0, 0, 0);
        }
      }
      float mt = st[0][0];
#pragma unroll
      for (int i = 1; i < 16; i++) mt = fmaxf(mt, st[0][i]);
#pragma unroll
      for (int i = 0; i < 16; i++) mt = fmaxf(mt, st[1][i]);
      mt = xhalf_max(mt);
      if (first || __any(mt > m[pl] + 8.f)) {
        const float mn = first ? mt : fmaxf(m[pl], mt);
        const float al = first ? 1.f : fexp2(m[pl] - mn);
        m[pl] = mn; lsum[pl] *= al;
#pragma unroll
        for (int i = 0; i < 16; i++) { O[pl][0][i] *= al; O[pl][1][i] *= al; }
      }
      const float mm = m[pl];
      float ls = 0.f;
#pragma unroll
      for (int kb = 0; kb < 2; kb++) {
#pragma unroll
        for (int i = 0; i < 16; i++) { float e = fexp2(st[kb][i] - mm); st[kb][i] = e; ls += e; }
#pragma unroll
        for (int s = 0; s < 2; s++)
#pragma unroll
          for (int q = 0; q < 4; q++) pb[kb][s][q] = pk2(st[kb][8 * s + 2 * q], st[kb][8 * s + 2 * q + 1]);
      }
      lsum[pl] += ls;
#pragma unroll
      for (int dt = 0; dt < 2; dt++)
#pragma unroll
        for (int kb = 0; kb < 2; kb++)
#pragma unroll
          for (int s = 0; s < 2; s++) {
            bf8 a = *(const bf8*)(Vb + (32 * dt + r) * LDT + 32 * kb + 16 * s + 8 * hh);
            O[pl][dt] = __builtin_amdgcn_mfma_f32_32x32x16_bf16(a, __builtin_bit_cast(bf8, pb[kb][s]), O[pl][dt], 0, 0, 0);
          }
      __builtin_amdgcn_sched_barrier(0);
    }
    if (kt + 1 < ntile) swrite(rkW, rvW, (kt + 1) & 1);
    __syncthreads();
  };
  for (int kt = 0; kt < ntile; kt += 2) {
    tile_body(kt, rkA, rvA, rkB, rvB);
    tile_body(kt + 1, rkB, rvB, rkA, rvA);
  }
  const float lam_init = 0.8f - 0.6f * __expf(-0.3f * (float)l);
  float d0 = 0.f, d1 = 0.f;
  for (int i = 0; i < 32; i++) {
    d0 += p.lam_q[(l * 2 + 0) * 32 + i] * p.lam_k[(l * 2 + 0) * 32 + i];
    d1 += p.lam_q[(l * 2 + 1) * 32 + i] * p.lam_k[(l * 2 + 1) * 32 + i];
  }
  const float lam = __expf(d0) - __expf(d1) + lam_init;
  const float i0 = 1.f / xhalf_sum(lsum[0]);
  const float i1 = lam / xhalf_sum(lsum[1]);
  float ss = 0.f;
#pragma unroll
  for (int dt = 0; dt < 2; dt++)
#pragma unroll
    for (int i = 0; i < 16; i++) { float o = O[0][dt][i] * i0 - O[1][dt][i] * i1; O[0][dt][i] = o; ss += o * o; }
  ss = xhalf_sum(ss);
  const float rs = rsqrtf(ss * (1.f / 64.f) + 1e-5f) * (1.f - lam_init);
  const float* gs = p.subln + l * 256 + hd * 64;
#pragma unroll
  for (int dt = 0; dt < 2; dt++)
#pragma unroll
    for (int i4 = 0; i4 < 4; i4++) {
      const int dv = 32 * dt + 8 * i4 + 4 * hh;
      u2 ov;
      ov[0] = pk2(O[0][dt][4 * i4 + 0] * rs * gs[dv + 0], O[0][dt][4 * i4 + 1] * rs * gs[dv + 1]);
      ov[1] = pk2(O[0][dt][4 * i4 + 2] * rs * gs[dv + 2], O[0][dt][4 * i4 + 3] * rs * gs[dv + 3]);
      *(u2*)(ACD + qrow * PACD + hd * 64 + dv) = ov;
    }
}

__device__ __forceinline__ void phase_m1(const Params& p, int l, unsigned char* smem) {
  const int NP = NR / 16, NC = 260 * 4;
  for (int it = blockIdx.x; it < NP + NC; it += gridDim.x) {
    if (it < NP) prepb_tile(p, l, it, (float*)smem);
    else retc1_item(p, l, it - NP, (float*)smem);
  }
}
__device__ __forceinline__ unsigned xb_xcc_id();
__device__ __forceinline__ void phase_m2(const Params& p, int l, unsigned char* smem) {
  __shared__ int s_item;
  unsigned* ctr = (unsigned*)(p.ws + OFF_CTR) + 16 * l;
  const int N0 = 128, N1 = N0 + 4160, N2 = N1 + 1040;
  for (;;) {
    if (threadIdx.x == 0) s_item = (int)atomicAdd(ctr, 1u);
    __syncthreads();
    const int it = s_item;
    __syncthreads();
    if (it >= N2) break;
    if (it < N0) retc2_item(p, l, it);
    else if (it < N1) rwkv_s1_item(p, it - N0, (u16*)smem);
    else attn_item<1>(p, l, it - N1, (u16*)smem);
  }
}
__device__ __forceinline__ void phase_m2b(const Params& p, int l, unsigned char* smem) {
  __shared__ int s_item2;
  unsigned* ctr = (unsigned*)(p.ws + OFF_CTR) + 16 * l;
  for (;;) {
    if (threadIdx.x == 0) s_item2 = (int)atomicAdd(ctr + 1, 1u);
    __syncthreads();
    const int it = s_item2;
    __syncthreads();
    if (it >= 8) break;
    rwkv_s2_item(p, it);
  }
  const int x0 = (int)(xb_xcc_id() & 7u);
  for (int dx = 0; dx < 8; dx++) {
    const int x = (x0 + dx) & 7;
    for (;;) {
      if (threadIdx.x == 0) s_item2 = (int)atomicAdd(ctr + 2 + x, 1u);
      __syncthreads();
      const int j = s_item2;
      __syncthreads();
      if (j >= 130) break;
      attnA2_item(p, l, j < 128 ? x * 128 + j : 1024 + x * 2 + (j - 128), (u16*)smem);
    }
  }
}
__device__ __forceinline__ void phase_m3(const Params& p, int l, unsigned char* smem) {
  const int NF = 2080, NC = 260 * 4;
  for (int it = blockIdx.x; it < NF + NC; it += gridDim.x) {
    if (it < NF) rwkv_s3_item(p, l, it, (u16*)smem);
    else retc3_item(p, l, it - NF, (u16*)smem);
  }
}

__device__ __forceinline__ void phase_merge(const Params& p, int l, unsigned char* smem) {
  const u16* H = (const u16*)(p.ws + OFF_H);
  const u16* winT = (const u16*)(p.ws + OFF_WA);
  const u16* wbrT = winT + (size_t)WINC * DM;
  const u16* ACD = (const u16*)(p.ws + OFF_ACD);
  const u16* GB = (const u16*)(p.ws + OFF_GB);
  u16* M = (u16*)(p.ws + OFF_M);
  GemmPipe1<2> pp;
  auto yptr = [&](int n, const u16*& yp, int& yl) {
    if (n == 0) { yp = ACD; yl = PACD; } else if (n == 1) { yp = GB; yl = 256; }
    else if (n == 2) { yp = ACD + 1280; yl = PACD; } else { yp = ACD + 1536; yl = PACD; }
  };
  int mt, nt;
  bool have = gemm_tile_of(0, 8, mt, nt);
  if (have) gemm_prefetch1<2>(pp, H + (size_t)mt * 128 * DM, DM, winT + ((size_t)3200 + nt * 128) * DM, DM);
  for (int kk = 0; have; kk++) {
    const int m0 = mt * 128, n0 = nt * 128;
    have = gemm_tile_of(kk + 1, 8, mt, nt);
    unsigned mpk[2][2][8];
#pragma unroll
    for (int mi = 0; mi < 2; mi++)
#pragma unroll
      for (int ni = 0; ni < 2; ni++)
#pragma unroll
        for (int i = 0; i < 8; i++) mpk[mi][ni][i] = 0u;
#pragma unroll 1
    for (int n = 0; n < 4; n++) {
      const u16* yp; int yl;
      yptr(n, yp, yl);
      unsigned sg[2][2][8];
      {
        f16 gacc[2][2];
        zero_acc<2>(gacc);
        gemm_main1<2>(gacc, pp, H + (size_t)m0 * DM, DM, winT + ((size_t)3200 + n * DM + n0) * DM, DM, DM, (u16*)smem);
        gemm_prefetch1<2>(pp, yp + (size_t)m0 * yl, yl, wbrT + ((size_t)n * DM + n0) * 256, 256);
#pragma unroll
        for (int mi = 0; mi < 2; mi++)
#pragma unroll
          for (int ni = 0; ni < 2; ni++)
#pragma unroll
            for (int i = 0; i < 8; i++) sg[mi][ni][i] = pk2(fsigmoid(gacc[mi][ni][2 * i]), fsigmoid(gacc[mi][ni][2 * i + 1]));
      }
      f16 yacc[2][2];
      zero_acc<2>(yacc);
      gemm_main1<2>(yacc, pp, yp + (size_t)m0 * yl, yl, wbrT + ((size_t)n * DM + n0) * 256, 256, 256, (u16*)smem);
      {
        int m0n = m0, n0n = n0, nn = n + 1;
        bool hv = true;
        if (nn == 4) { hv = have; m0n = mt * 128; n0n = nt * 128; nn = 0; }
        if (hv) gemm_prefetch1<2>(pp, H + (size_t)m0n * DM, DM, winT + ((size_t)3200 + nn * DM + n0n) * DM, DM);
      }
#pragma unroll
      for (int mi = 0; mi < 2; mi++)
#pragma unroll
        for (int ni = 0; ni < 2; ni++)
#pragma unroll
          for (int i = 0; i < 8; i++) {
            const float a = lo16(mpk[mi][ni][i]) + lo16(sg[mi][ni][i]) * yacc[mi][ni][2 * i];
            const float c2 = hi16(mpk[mi][ni][i]) + hi16(sg[mi][ni][i]) * yacc[mi][ni][2 * i + 1];
            mpk[mi][ni][i] = pk2(a, c2);
          }
    }
    f16 macc[2][2];
#pragma unroll
    for (int mi = 0; mi < 2; mi++)
#pragma unroll
      for (int ni = 0; ni < 2; ni++)
#pragma unroll
        for (int i = 0; i < 8; i++) { macc[mi][ni][2 * i] = lo16(mpk[mi][ni][i]); macc[mi][ni][2 * i + 1] = hi16(mpk[mi][ni][i]); }
    gemm_epi<2>(macc, (float*)smem, [&](int row, int c8, const float* e) {
      store8(M + (size_t)(m0 + row) * DM + n0 + c8, e);
    });
  }
}

template <int ACT>
__device__ __forceinline__ void phase_gemm(const u16* A, const u16* WT, u16* OUT, int N, int K, unsigned char* smem) {
  const int ntn = N >> 7;
  GemmPipe<2> pp;
  int mt, nt;
  bool have = gemm_tile_of(0, ntn, mt, nt);
  if (have) gemm_prefetch<2>(pp, A + (size_t)mt * 128 * K, K, WT + (size_t)nt * 128 * K, K);
  for (int kk = 0; have; kk++) {
    const int m0 = mt * 128, n0 = nt * 128;
    f16 acc[2][2];
    zero_acc<2>(acc);
    gemm_main<2>(acc, pp, A + (size_t)m0 * K, K, WT + (size_t)n0 * K, K, K, (u16*)smem);
    have = gemm_tile_of(kk + 1, ntn, mt, nt);
    if (have) gemm_prefetch<2>(pp, A + (size_t)mt * 128 * K, K, WT + (size_t)nt * 128 * K, K);
    gemm_epi<2>(acc, (float*)smem, [&](int row, int c8, const float* e) {
      float v[8];
#pragma unroll
      for (int i = 0; i < 8; i++) { float x = e[i]; if (ACT == 1) { x = fmaxf(x, 0.f); x = x * x; } v[i] = x; }
      store8(OUT + (size_t)(m0 + row) * N + n0 + c8, v);
    });
  }
}

__device__ __forceinline__ unsigned xb_xcc_id() { return (unsigned)__builtin_amdgcn_s_getreg((3 << 11) | 20) & 0xFu; }

constexpr int PH_PER_LAYER = 11;
constexpr int NPHASE = 2 + DEPTH * PH_PER_LAYER;

__device__ __forceinline__ void run_phase(const Params& p, int ph, unsigned char* smem) {
  if (ph == 0) { phase_pro(p, smem); return; }
  if (ph == 1) { phase_rows(p, 0, 0); return; }
  const int l = (ph - 2) / PH_PER_LAYER, s = (ph - 2) % PH_PER_LAYER;
  unsigned char* ws = p.ws;
  switch (s) {
    case 0: phase_gemm1(p, l, smem); break;
    case 1: phase_m1(p, l, smem); break;
    case 2: phase_m2(p, l, smem); break;
    case 3: phase_m2b(p, l, smem); break;
    case 4: phase_m3(p, l, smem); break;
    case 5: phase_merge(p, l, smem); break;
    case 6: phase_gemm<0>((const u16*)(ws + OFF_M), (const u16*)(ws + OFF_WA) + (size_t)WINC * DM + (size_t)4 * DM * 256,
                          (u16*)(ws + OFF_MO), DM, DM, smem); break;
    case 7: phase_rows(p, l, 1); break;
    case 8: phase_gemm<1>((const u16*)(ws + OFF_H), (const u16*)(ws + OFF_WM), (u16*)(ws + OFF_U), DFF, DM, smem); break;
    case 9: phase_gemm<0>((const u16*)(ws + OFF_U), (const u16*)(ws + OFF_WM) + (size_t)DFF * DM, (u16*)(ws + OFF_DN), DM, DFF, smem); break;
    case 10: phase_rows(p, l, 2); if (l + 1 < DEPTH) wconv_layer(p, l + 1, smem); break;
  }
}

__global__ void __launch_bounds__(256, 2) mega_kernel(Params p) {
  __shared__ __attribute__((aligned(16))) unsigned char smem[SMEM_BYTES];
  cg::grid_group grid = cg::this_grid();
  for (int ph = 0; ph < NPHASE; ph++) {
    run_phase(p, ph, smem);
    if (ph + 1 < NPHASE) {
      grid.sync();
    }
  }
}

#if MULTI_LAUNCH
__global__ void __launch_bounds__(256, 2) phase_kernel(Params p, int ph) {
  __shared__ __attribute__((aligned(16))) unsigned char smem[SMEM_BYTES];
  run_phase(p, ph, smem);
}
#endif

extern "C" void kernel_launch(void* const* d_in, const int* in_sizes, int n_in, void* d_out, int out_size, void* d_ws,
                              size_t ws_size, hipStream_t stream) {
  Params p{};
  const float** pp = (const float**)&p;
  for (int i = 0; i < 32; i++) pp[i] = (const float*)d_in[i];
  p.out = (float*)d_out;
  p.ws = (unsigned char*)d_ws;
#if MULTI_LAUNCH
  hipMemsetAsync((unsigned char*)d_ws + OFF_CTR, 0, 256, stream);
  for (int ph = 0; ph < NPHASE; ph++) phase_kernel<<<dim3(512), dim3(256), 0, stream>>>(p, ph);
#else
  static int grid_blocks = 0;
  if (!grid_blocks) {
    int dev = 0, cus = 0, per_cu = 0;
    hipGetDevice(&dev);
    hipDeviceGetAttribute(&cus, hipDeviceAttributeMultiprocessorCount, dev);
    hipOccupancyMaxActiveBlocksPerMultiprocessor(&per_cu, mega_kernel, 256, 0);
    if (per_cu > 2) per_cu = 2;
    if (per_cu < 1) per_cu = 1;
    grid_blocks = cus * per_cu;
  }
  (void)hipMemsetAsync((unsigned char*)d_ws + OFF_CTR, 0, 4096, stream);
  void* args[] = {&p};
  hipError_t e = hipLaunchCooperativeKernel((void*)mega_kernel, dim3(grid_blocks), dim3(256), args, 0, stream);
  if (e != hipSuccess) fprintf(stderr, "cooperative launch failed: %s (grid %d)\n", hipGetErrorString(e), grid_blocks);
#endif
}
```
